# Optimizing an MI355X kernel written in HIP

```python
import jax, jax.numpy as jnp
from jax import lax
import numpy as np

D_MODEL = 1024
BATCH = 16
SEQ = 2048
DEPTH = 4

HEAD_DIM = 64
ROPE_THETA = 10000.0
A_HEADS = 8
A_CONFIGS = ((128, 1), (512, 4), (2048, 16))
B_HEADS = 8
B_KV_HEADS = 2
B_WINDOW = 128
C_HEADS = 8
IDX_HEADS = 8
IDX_DIM = 64
TOPK_MAX = 256
QUERY_BLOCK = 128
BAND_BLOCK = 128
D_FF = 2816
LN_EPS = 1e-5
DN_ALPHA = (2 * DEPTH) ** 0.25
DN_BETA = (8 * DEPTH) ** -0.25

A_W = A_HEADS * HEAD_DIM
B_QW = B_HEADS * HEAD_DIM
B_KW = B_KV_HEADS * HEAD_DIM
C_W = C_HEADS * HEAD_DIM
IN_SIZES = (A_W, A_W, A_W,
            B_QW, B_KW, B_KW,
            C_W, HEAD_DIM, HEAD_DIM,
            IDX_HEADS * IDX_DIM, IDX_DIM, IDX_HEADS,
            D_MODEL, D_MODEL, D_MODEL)
D_IN = sum(IN_SIZES)

kernel_name = "hybrid_dilated_swa_dsa_macaron_deepnorm"


def layer_norm(x, g, b):
    xf = x.astype(jnp.float32)
    mu = xf.mean(-1, keepdims=True)
    var = jnp.square(xf - mu).mean(-1, keepdims=True)
    y = (xf - mu) * lax.rsqrt(var + LN_EPS)
    return (y * g.astype(jnp.float32) + b.astype(jnp.float32)).astype(x.dtype)


def rope_tables(positions, dim):
    inv = ROPE_THETA ** (-jnp.arange(0, dim, 2, dtype=jnp.float32) / dim)
    ang = positions.astype(jnp.float32)[..., None] * inv
    return jnp.cos(ang), jnp.sin(ang)


def apply_rope(t, cos, sin):
    tf = t.astype(jnp.float32)
    t1, t2 = jnp.split(tf, 2, axis=-1)
    c = cos[:, :, None, :]
    s = sin[:, :, None, :]
    return jnp.concatenate([t1 * c - t2 * s, t2 * c + t1 * s], axis=-1).astype(t.dtype)


def swiglu(x, w_in, w_out):
    gate, up = jnp.split(x @ w_in, 2, axis=-1)
    return (jax.nn.silu(gate) * up) @ w_out


def banded_attention(q, k, v, max_dist, sink=None):
    n, l, h, dh = q.shape
    g = k.shape[2]
    r = h // g
    blk = BAND_BLOCK
    nb = -(-l // blk)
    pad = nb * blk - l
    qp = jnp.pad(q, ((0, 0), (0, pad), (0, 0), (0, 0))).reshape(n, nb, blk, g, r, dh)

    def kv_blocks(t):
        tp = jnp.pad(t, ((0, 0), (blk, pad), (0, 0), (0, 0))).reshape(n, nb + 1, blk, g, dh)
        return jnp.concatenate([tp[:, :-1], tp[:, 1:]], axis=2)

    kb, vb = kv_blocks(k), kv_blocks(v)
    s = jnp.einsum('nbqgrd,nbkgd->nbgrqk', qp, kb, preferred_element_type=jnp.float32) * (dh ** -0.5)
    qi = jnp.arange(blk)[:, None]
    kj = jnp.arange(2 * blk)[None, :]
    dist = qi + blk - kj
    kpos = jnp.arange(nb)[:, None, None] * blk - blk + kj[None]
    valid = (dist >= 0) & (dist <= max_dist) & (kpos >= 0)
    s = jnp.where(valid[:, None, None], s, -jnp.inf)
    m = s.max(-1)
    if sink is not None:
        sk = sink.astype(jnp.float32).reshape(g, r)[:, :, None]
        m = jnp.maximum(m, sk)
    p = jnp.exp(s - m[..., None])
    den = p.sum(-1)
    if sink is not None:
        den = den + jnp.exp(sk - m)
    o = jnp.einsum('nbgrqk,nbkgd->nbqgrd', p.astype(v.dtype), vb, preferred_element_type=jnp.float32)
    o = o / den.transpose(0, 1, 4, 2, 3)[..., None]
    o = o.reshape(n, nb * blk, h, dh)[:, :l].astype(q.dtype)
    lse = (m + jnp.log(den)).transpose(0, 1, 4, 2, 3).reshape(n, nb * blk, h)[:, :l]
    return o, lse


def dilated_attention(q, k, v):
    b, s, h, dh = q.shape
    outs, lses = [], []
    for window, dil in A_CONFIGS:
        def fold(t):
            return t.reshape(b, s // dil, dil, h, dh).transpose(0, 2, 1, 3, 4).reshape(b * dil, s // dil, h, dh)
        o, lse = banded_attention(fold(q), fold(k), fold(v), window // dil)
        outs.append(o.reshape(b, dil, s // dil, h, dh).transpose(0, 2, 1, 3, 4).reshape(b, s, h, dh))
        lses.append(lse.reshape(b, dil, s // dil, h).transpose(0, 2, 1, 3).reshape(b, s, h))
    wts = jax.nn.softmax(jnp.stack(lses, 0), axis=0)
    o = jnp.einsum('cbsh,cbshd->bshd', wts, jnp.stack(outs, 0).astype(jnp.float32))
    return o.astype(q.dtype)


def dsa_attention(q, k, v, q_idx, k_idx, w_idx):
    b, s, h, dh = q.shape
    k_sel = min(TOPK_MAX, s // 4)
    nq = s // QUERY_BLOCK
    key_pos = jnp.arange(s)
    gather = jax.vmap(lambda t, ix: t[ix])

    def block(i):
        start = i * QUERY_BLOCK
        qb = lax.dynamic_slice_in_dim(q, start, QUERY_BLOCK, axis=1)
        qib = lax.dynamic_slice_in_dim(q_idx, start, QUERY_BLOCK, axis=1)
        wb = lax.dynamic_slice_in_dim(w_idx, start, QUERY_BLOCK, axis=1)
        qpos = start + jnp.arange(QUERY_BLOCK)
        causal = key_pos[None, :] <= qpos[:, None]
        dots = jnp.einsum('bqhd,bsd->bqhs', qib, k_idx, preferred_element_type=jnp.float32)
        score = jnp.einsum('bqhs,bqh->bqs', jax.nn.relu(dots), wb.astype(jnp.float32))
        score = jnp.where(causal[None], score, -jnp.inf)
        _, idx = lax.top_k(score, k_sel)
        sel_valid = idx <= qpos[None, :, None]
        kg = gather(k, idx)
        vg = gather(v, idx)
        att = jnp.einsum('bqhd,bqkd->bhqk', qb, kg, preferred_element_type=jnp.float32) * (dh ** -0.5)
        att = jnp.where(sel_valid[:, None], att, -jnp.inf)
        p = jax.nn.softmax(att, axis=-1)
        return jnp.einsum('bhqk,bqkd->bqhd', p.astype(v.dtype), vg,
                          preferred_element_type=jnp.float32).astype(q.dtype)

    out = lax.map(block, jnp.arange(nq))
    return out.transpose(1, 0, 2, 3, 4).reshape(b, s, h, dh)


def hybrid_mixer(x, cos, sin, w_in, sink_b, w_br_a, w_br_b, w_br_c, w_out):
    b, s, _ = x.shape
    proj = x @ w_in
    splits = [int(c) for c in np.cumsum(IN_SIZES)[:-1]]
    (qa, ka, va, qb, kb, vb, qc, kc, vc, qi, ki, wi, ga, gb, gc) = jnp.split(proj, splits, axis=-1)

    def heads(t, nh):
        return t.reshape(b, s, nh, -1)

    o_a = dilated_attention(apply_rope(heads(qa, A_HEADS), cos, sin),
                            apply_rope(heads(ka, A_HEADS), cos, sin),
                            heads(va, A_HEADS)).reshape(b, s, A_W)
    o_b, _ = banded_attention(apply_rope(heads(qb, B_HEADS), cos, sin),
                              apply_rope(heads(kb, B_KV_HEADS), cos, sin),
                              heads(vb, B_KV_HEADS), B_WINDOW - 1, sink_b)
    o_b = o_b.reshape(b, s, B_QW)
    o_c = dsa_attention(apply_rope(heads(qc, C_HEADS), cos, sin),
                        apply_rope(heads(kc, 1), cos, sin)[:, :, 0],
                        vc,
                        apply_rope(heads(qi, IDX_HEADS), cos, sin),
                        apply_rope(heads(ki, 1), cos, sin)[:, :, 0],
                        wi).reshape(b, s, C_W)
    merged = (jax.nn.sigmoid(ga) * (o_a @ w_br_a)
              + jax.nn.sigmoid(gb) * (o_b @ w_br_b)
              + jax.nn.sigmoid(gc) * (o_c @ w_br_c))
    return merged @ w_out


def setup_inputs(seed: int = 0) -> dict:
    key = jax.random.key(seed)
    ks = jax.random.split(key, 16)
    f32 = jnp.float32

    def nrm(k, shape, scale):
        return jax.random.normal(k, shape, f32) * scale

    x = jax.random.normal(ks[0], (BATCH, SEQ, D_MODEL), f32)
    offs = jax.random.randint(ks[1], (BATCH, 1), 0, 4096, dtype=jnp.int32)
    positions = jnp.arange(SEQ, dtype=jnp.int32)[None, :] + offs
    return {
        "x": x,
        "positions": positions,
        "w_in": nrm(ks[2], (DEPTH, D_MODEL, D_IN), D_MODEL ** -0.5),
        "sink_b": nrm(ks[3], (DEPTH, B_HEADS), 0.5),
        "w_br_a": nrm(ks[4], (DEPTH, A_W, D_MODEL), A_W ** -0.5),
        "w_br_b": nrm(ks[5], (DEPTH, B_QW, D_MODEL), B_QW ** -0.5),
        "w_br_c": nrm(ks[6], (DEPTH, C_W, D_MODEL), C_W ** -0.5),
        "w_out": nrm(ks[7], (DEPTH, D_MODEL, D_MODEL), D_MODEL ** -0.5 * DN_BETA),
        "ffn1_in": nrm(ks[8], (DEPTH, D_MODEL, 2 * D_FF), D_MODEL ** -0.5),
        "ffn1_out": nrm(ks[9], (DEPTH, D_FF, D_MODEL), D_FF ** -0.5 * DN_BETA),
        "ffn2_in": nrm(ks[10], (DEPTH, D_MODEL, 2 * D_FF), D_MODEL ** -0.5),
        "ffn2_out": nrm(ks[11], (DEPTH, D_FF, D_MODEL), D_FF ** -0.5 * DN_BETA),
        "ln_g": 1.0 + nrm(ks[12], (DEPTH, 3, D_MODEL), 0.02),
        "ln_b": nrm(ks[13], (DEPTH, 3, D_MODEL), 0.02),
    }


def reference(x, positions, w_in, sink_b, w_br_a, w_br_b, w_br_c, w_out,
              ffn1_in, ffn1_out, ffn2_in, ffn2_out, ln_g, ln_b):
    cos, sin = rope_tables(positions, HEAD_DIM)
    for l in range(DEPTH):
        x = layer_norm(DN_ALPHA * x + 0.5 * swiglu(x, ffn1_in[l], ffn1_out[l]), ln_g[l, 0], ln_b[l, 0])
        x = layer_norm(DN_ALPHA * x + hybrid_mixer(x, cos, sin, w_in[l], sink_b[l], w_br_a[l],
                                                   w_br_b[l], w_br_c[l], w_out[l]),
                       ln_g[l, 1], ln_b[l, 1])
        x = layer_norm(DN_ALPHA * x + 0.5 * swiglu(x, ffn2_in[l], ffn2_out[l]), ln_g[l, 2], ln_b[l, 2])
    return x
```

```cpp
#define BAND_NQ 4
#include <hip/hip_runtime.h>
#include <hip/hip_cooperative_groups.h>
#include <cstdio>
#include <cstdint>
namespace cg = cooperative_groups;

#ifndef MK_MULTI
#define MK_MULTI 0
#endif

constexpr int T_ = 32768, D_ = 1024, FF_ = 2816, SEQ_ = 2048, NB_ = 16, DEPTH_ = 4;
constexpr int NP_ = 3584, NG_ = 3072, NO_ = 1536, DIN_ = 6600;
constexpr float LN_EPS_ = 1e-5f;
constexpr float ALPHA_ = 1.6817928305074292f;
constexpr float SC2_ = 0.125f * 1.4426950408889634f;
constexpr int PC_QA = 0, PC_KA = 512, PC_QB = 1024, PC_QC = 1536, PC_QI = 2048, PC_KB = 2560, PC_KC = 2688, PC_KI = 2752, PC_VA = 2816, PC_VB = 3328, PC_VC = 3456, PC_WI = 3520;
constexpr int SC_QA = 0, SC_KA = 512, SC_VA = 1024, SC_QB = 1536, SC_KB = 2048, SC_VB = 2176, SC_QC = 2304, SC_KC = 2816, SC_VC = 2880, SC_QI = 2944, SC_KI = 3456, SC_WI = 3520, SC_G = 3528;

constexpr size_t MiB = 1u << 20;
constexpr size_t WS_STATS = 0;
constexpr size_t WS_ROPE  = 8 * MiB;
constexpr size_t WS_LNV   = 16 * MiB;
constexpr size_t WS_AUX   = WS_LNV + 8192;
constexpr int AUX_G1 = 0, AUX_B1 = 5632, AUX_G3 = 11264, AUX_B3 = 14848, AUX_G4 = 18432, AUX_B4 = 21504, AUX_G7 = 24576, AUX_B7 = 30208, AUX_END = 35840;
constexpr size_t WS_LSE   = 17 * MiB;
constexpr size_t WS_YB    = 20 * MiB;
constexpr size_t WS_W     = 84 * MiB;
constexpr size_t WE_1 = 0, WE_2 = WE_1 + (size_t)5632 * 1024, WE_3 = WE_2 + (size_t)1024 * 2816, WE_4 = WE_3 + (size_t)3584 * 1024, WE_5 = WE_4 + (size_t)3072 * 1024,
                 WE_6 = WE_5 + (size_t)3072 * 512, WE_7 = WE_6 + (size_t)1024 * 1024, WE_8 = WE_7 + (size_t)5632 * 1024, WE_END = WE_8 + (size_t)1024 * 2816;
static_assert(WE_END * 2 <= 52 * MiB, "weights");
constexpr size_t WS_BIG   = 136 * MiB;
constexpr size_t WS_OBUF  = 360 * MiB;
constexpr size_t WS_ACX   = 456 * MiB;
constexpr size_t WS_END   = 520 * MiB;
static_assert(WS_AUX + AUX_END * 4 <= WS_LSE && WS_LSE + 3 * MiB <= WS_YB && WS_BIG + (size_t)T_ * NP_ * 2 <= WS_OBUF, "ws map");

#define LAS __attribute__((address_space(3)))
typedef unsigned short bf16_t;
typedef short bf16x8 __attribute__((ext_vector_type(8)));
typedef short s16x4 __attribute__((ext_vector_type(4)));
typedef float f32x4 __attribute__((ext_vector_type(4)));
typedef float f32x2 __attribute__((ext_vector_type(2)));
typedef unsigned u32x4 __attribute__((ext_vector_type(4)));
typedef unsigned u32x2 __attribute__((ext_vector_type(2)));
__device__ __forceinline__ unsigned f2bf(float f) { unsigned u = __float_as_uint(f); return (u + 0x7fffu + ((u >> 16) & 1u)) >> 16; }
__device__ __forceinline__ float bf2f(unsigned v) { return __uint_as_float(v << 16); }
typedef __bf16 bf16x2_t __attribute__((ext_vector_type(2)));
__device__ __forceinline__ unsigned cvt_pk_bf16(float lo, float hi) { const f32x2 v = {lo, hi}; const bf16x2_t b = __builtin_convertvector(v, bf16x2_t); return __builtin_bit_cast(unsigned, b); }
__device__ __forceinline__ float fast_exp2(float x) { return __builtin_amdgcn_exp2f(x); }
__device__ __forceinline__ float fast_rcp(float x) { return __builtin_amdgcn_rcpf(x); }
__device__ __forceinline__ float xmax16(float v) { const auto r = __builtin_amdgcn_permlane16_swap(__float_as_uint(v), __float_as_uint(v), false, false); return fmaxf(__uint_as_float(r[0]), __uint_as_float(r[1])); }
__device__ __forceinline__ float xmax32(float v) { const auto r = __builtin_amdgcn_permlane32_swap(__float_as_uint(v), __float_as_uint(v), false, false); return fmaxf(__uint_as_float(r[0]), __uint_as_float(r[1])); }
__device__ __forceinline__ float xsum16(float v) { const auto r = __builtin_amdgcn_permlane16_swap(__float_as_uint(v), __float_as_uint(v), false, false); return __uint_as_float(r[0]) + __uint_as_float(r[1]); }
__device__ __forceinline__ float xsum32(float v) { const auto r = __builtin_amdgcn_permlane32_swap(__float_as_uint(v), __float_as_uint(v), false, false); return __uint_as_float(r[0]) + __uint_as_float(r[1]); }
__device__ __forceinline__ float sigmoid_f(float x) { return fast_rcp(1.0f + fast_exp2(-1.4426950408889634f * x)); }
__device__ __forceinline__ void row_stats(const float* st, int row, int fq, float& mu, float& rstd) {
    const f32x4* p = (const f32x4*)(st + (size_t)row * 32 + fq * 8);
    const f32x4 a = p[0], b = p[1];
    float s1 = (a[0] + a[2]) + (b[0] + b[2]), s2 = (a[1] + a[3]) + (b[1] + b[3]);
    s1 = xsum32(xsum16(s1)); s2 = xsum32(xsum16(s2));
    mu = s1 * (1.0f / 1024.0f); const float var = fmaxf(s2 * (1.0f / 1024.0f) - mu * mu, 0.f); rstd = rsqrtf(var + LN_EPS_);
}

namespace pg8 {
#define PG8_LAS __attribute__((address_space(3)))
constexpr int BM = 256, BK = 64, HALF = 128, HTB = HALF * BK * 2, STAGE_BYTES = 8 * HTB, NXCD = 8, WGM = 8;
__host__ __device__ __forceinline__ int lds_byte(int r, int c) { const int st = (r >> 4) * 2 + (c >> 5), rr = r & 15, cc = c & 31, ob = rr * 64 + cc * 2; return st * 1024 + (ob ^ (((ob >> 9) & 1) << 5)); }
__host__ __device__ __forceinline__ void stage_rc(int b, int& R, int& C) { const int st = b / 1024, sb = b % 1024, swz = sb ^ (((sb >> 9) & 1) << 5); R = (st >> 1) * 16 + swz / 64; C = (st & 1) * 32 + (swz % 64) / 2; }
__host__ __device__ __forceinline__ int perm32(int rho) { const int n = rho >> 4, i = rho & 15; return 8 * (i >> 2) + 4 * n + (i & 3); }
struct Unit { int pm, pn, ac; };
struct Gemm { const bf16_t* A; const bf16_t* Bt; int lda, K; };
struct StaticOrder {
    int nM, nN, nwg, G, c;
    __device__ void init(int M, int N, int G_, int c_) { nM = M / BM; nN = N / BM; nwg = nM * nN; G = G_; c = c_; }
    __device__ bool next(int i, Unit& u) const {
        const long L = (long)i * G + c; if (L >= nwg) return false;
        int wgid = (int)L; { const int q = nwg / NXCD, r = nwg % NXCD, xcd = wgid % NXCD, off = wgid / NXCD; wgid = (xcd < r ? xcd * (q + 1) : r * (q + 1) + (xcd - r) * q) + off; }
        const int nig = WGM * nN, gid = wgid / nig, fm = gid * WGM, gsz = (nM - fm) < WGM ? (nM - fm) : WGM;
        u.pm = fm + ((wgid % nig) % gsz); u.pn = (wgid % nig) / gsz; u.ac = 0; return true;
    }
    __device__ __forceinline__ void a_ready(const Unit&) const {}
    __device__ __forceinline__ void done(const Unit&) const {}
};
struct BranchOrder {
    StaticOrder so;
    __device__ void init(int G_, int c_) { so.init(T_, 1024, G_, c_); }
    __device__ bool next(int i, Unit& u) const { const int br = i % 3; if (!so.next(i / 3, u)) return false; u.pn += 4 * br; u.ac = br * 512 * 2; return true; }
    __device__ __forceinline__ void a_ready(const Unit&) const {}
    __device__ __forceinline__ void done(const Unit&) const {}
};
template <class Epi, class Sched, bool ALIGN_EPI = false, bool SP2 = false>
__device__ __forceinline__ void gemm_phase(PG8_LAS unsigned char* lds, const Gemm g, const Sched& S, const Epi& E) {
    int tid_ = threadIdx.x; asm volatile("" : "+v"(tid_));
    const int tid = tid_, wid = __builtin_amdgcn_readfirstlane(tid >> 6), lane = tid & 63, wr = wid >> 2, wc = wid & 3, fr = lane & 15, fq = lane >> 4;
    const int K = g.K, nt = K / BK, LDA = g.lda;
    unsigned voffA[2], voffB[2];
#pragma unroll
    for (int i = 0; i < 2; ++i) { int R, C; stage_rc(tid * 16 + i * 8192, R, C); const int Rb = Epi::PERM ? ((R & ~31) + perm32(R & 31)) : R;
        voffA[i] = (unsigned)(R * LDA + C) * 2u; voffB[i] = (unsigned)(Rb * K + C) * 2u; }
    const size_t kstep = (size_t)(BK * 2);
    const size_t hstepB = (size_t)HALF * K * 2, hstepA = (size_t)HALF * LDA * 2;
    const size_t tstepA = 2 * hstepA, tstepB = 2 * hstepB;
    const unsigned ldsw = (unsigned)wid * 1024u;
    const int aoff = lds_byte(wr * 64 + fr, fq * 8), boff = lds_byte(wc * 32 + fr, fq * 8);
#define PG8_SA(b, h) (((b) * 2 + (h)) * HTB)
#define PG8_SB(b, h) ((4 + (b) * 2 + (h)) * HTB)
#define PG8_STAGE(bufoff, gbase, voff) do { _Pragma("unroll") for (int _i = 0; _i < 2; ++_i) \
        __builtin_amdgcn_global_load_lds((const unsigned*)((const char*)(gbase) + (voff)[_i]), (PG8_LAS unsigned*)(lds + (bufoff) + ldsw + _i * 8192), 16, 0, 0); } while (0)
#define PG8_LDA(dst, b, h) do { _Pragma("unroll") for (int m = 0; m < 4; ++m) _Pragma("unroll") for (int k = 0; k < 2; ++k) dst[m][k] = *(const PG8_LAS bf16x8*)(lds + PG8_SA(b, h) + aoff + m * 2048 + k * 1024); } while (0)
#define PG8_LDB(dst, b, h) do { _Pragma("unroll") for (int n = 0; n < 2; ++n) _Pragma("unroll") for (int k = 0; k < 2; ++k) dst[n][k] = *(const PG8_LAS bf16x8*)(lds + PG8_SB(b, h) + boff + n * 2048 + k * 1024); } while (0)
#define PG8_MMA(ai, bj, At, Bt) do { __builtin_amdgcn_s_setprio(1); _Pragma("unroll") for (int m = 0; m < 4; ++m) _Pragma("unroll") for (int n = 0; n < 2; ++n) _Pragma("unroll") for (int k = 0; k < 2; ++k) \
        acc[ai][bj][m][n] = __builtin_amdgcn_mfma_f32_16x16x32_bf16(Bt[n][k], At[m][k], acc[ai][bj][m][n], 0, 0, 0); __builtin_amdgcn_s_setprio(0); } while (0)
#define PG8_WAIT_V(n) asm volatile("s_waitcnt vmcnt(" #n ")" ::: "memory")
#define PG8_WAIT_L(n) asm volatile("s_waitcnt lgkmcnt(" #n ")" ::: "memory")
#define PG8_BAR __builtin_amdgcn_s_barrier()
#define PG8_SCHED __builtin_amdgcn_sched_barrier(0)
    Unit cur, nxt; int ui = 0;
    if (!S.next(0, cur)) return;
    f32x4 acc[2][2][4][2];
#pragma unroll
    for (int a = 0; a < 2; ++a)
#pragma unroll
        for (int b = 0; b < 2; ++b)
#pragma unroll
            for (int m = 0; m < 4; ++m)
#pragma unroll
                for (int n = 0; n < 2; ++n) acc[a][b][m][n] = (f32x4){0.f, 0.f, 0.f, 0.f};
    bf16x8 At[4][2], B0[2][2], B1[2][2];
    const char* cA = (const char*)g.A + (size_t)cur.pm * tstepA + cur.ac; const char* cB = (const char*)g.Bt + (size_t)cur.pn * tstepB;
    S.a_ready(cur);
    if constexpr (SP2) {
        PG8_STAGE(PG8_SB(0, 0), cB, voffB); PG8_STAGE(PG8_SB(0, 1), cB + hstepB, voffB); PG8_STAGE(PG8_SA(0, 0), cA, voffA); PG8_STAGE(PG8_SA(0, 1), cA + hstepA, voffA);
        if (wr == 1) PG8_BAR;
        PG8_WAIT_V(2); PG8_BAR;
        PG8_STAGE(PG8_SB(1, 0), cB + kstep, voffB); PG8_STAGE(PG8_SA(1, 0), cA + kstep, voffA); PG8_STAGE(PG8_SB(1, 1), cB + hstepB + kstep, voffB);
        PG8_WAIT_V(6); PG8_BAR;
    } else {
        PG8_STAGE(PG8_SB(0, 0), cB, voffB); PG8_STAGE(PG8_SA(0, 0), cA, voffA); PG8_STAGE(PG8_SB(0, 1), cB + hstepB, voffB); PG8_STAGE(PG8_SA(0, 1), cA + hstepA, voffA);
        if (wr == 1) PG8_BAR;
        PG8_WAIT_V(4); PG8_BAR;
        PG8_STAGE(PG8_SB(1, 0), cB + kstep, voffB); PG8_STAGE(PG8_SA(1, 0), cA + kstep, voffA); PG8_STAGE(PG8_SB(1, 1), cB + hstepB + kstep, voffB);
        PG8_WAIT_V(6); PG8_BAR;
    }
    for (;;) {
        const bool has_next = S.next(ui + 1, nxt);
        const char* nA = has_next ? (const char*)g.A + (size_t)nxt.pm * tstepA + nxt.ac : cA; const char* nB = has_next ? (const char*)g.Bt + (size_t)nxt.pn * tstepB : cB;
        for (int t = 0; t < nt; t += 2) {
            if constexpr (Epi::MIDK) { if (t == 8 || t == 16) E.mid(acc, cur, t, wr, wc, fr, fq); }
            const bool last = (t == nt - 2);
            const char* a1 = cA + (size_t)(t + 1) * kstep;
            const char* a2 = last ? nA : cA + (size_t)(t + 2) * kstep; const char* b2 = last ? nB : cB + (size_t)(t + 2) * kstep;
            const char* a3 = a2 + kstep; const char* b3 = b2 + kstep;
            if (last && has_next) S.a_ready(nxt);
            if constexpr (SP2) {
            PG8_LDB(B0, 0, 0); PG8_LDB(B1, 0, 1); PG8_SCHED; PG8_LDA(At, 0, 0); PG8_STAGE(PG8_SA(1, 1), a1 + hstepA, voffA);
            PG8_WAIT_V(8); PG8_WAIT_L(0); PG8_BAR; PG8_MMA(0, 0, At, B0); PG8_MMA(0, 1, At, B1); PG8_BAR; PG8_SCHED;
            PG8_LDA(At, 0, 1); PG8_STAGE(PG8_SB(0, 0), b2, voffB); PG8_STAGE(PG8_SB(0, 1), b2 + hstepB, voffB); PG8_STAGE(PG8_SA(0, 0), a2, voffA);
            PG8_WAIT_V(8); PG8_WAIT_L(0); PG8_BAR; PG8_MMA(1, 0, At, B0); PG8_MMA(1, 1, At, B1); PG8_BAR; PG8_SCHED;
            PG8_LDB(B0, 1, 0); PG8_LDB(B1, 1, 1); PG8_SCHED; PG8_LDA(At, 1, 0); PG8_STAGE(PG8_SA(0, 1), a2 + hstepA, voffA);
            PG8_WAIT_V(8); PG8_WAIT_L(0); PG8_BAR; PG8_MMA(0, 0, At, B0); PG8_MMA(0, 1, At, B1); PG8_BAR; PG8_SCHED;
            PG8_LDA(At, 1, 1); PG8_STAGE(PG8_SB(1, 0), b3, voffB); PG8_STAGE(PG8_SB(1, 1), b3 + hstepB, voffB); PG8_STAGE(PG8_SA(1, 0), a3, voffA);
            PG8_WAIT_V(8); PG8_WAIT_L(0); PG8_BAR; PG8_MMA(1, 0, At, B0); PG8_MMA(1, 1, At, B1); PG8_BAR; PG8_SCHED;
            } else {
            PG8_LDB(B0, 0, 0); PG8_SCHED; PG8_LDA(At, 0, 0); PG8_STAGE(PG8_SA(1, 1), a1 + hstepA, voffA);
            PG8_WAIT_L(8); PG8_BAR; PG8_WAIT_L(0); PG8_MMA(0, 0, At, B0); PG8_BAR; PG8_SCHED;
            PG8_LDB(B1, 0, 1); PG8_STAGE(PG8_SB(0, 0), b2, voffB);
            PG8_BAR; PG8_WAIT_L(0); PG8_MMA(0, 1, At, B1); PG8_BAR;
            PG8_LDA(At, 0, 1); PG8_STAGE(PG8_SA(0, 0), a2, voffA);
            PG8_BAR; PG8_WAIT_L(0); PG8_MMA(1, 0, At, B0); PG8_BAR; PG8_SCHED;
            PG8_STAGE(PG8_SB(0, 1), b2 + hstepB, voffB);
            PG8_WAIT_V(6); PG8_BAR; PG8_MMA(1, 1, At, B1); PG8_BAR;
            PG8_LDB(B0, 1, 0); PG8_SCHED; PG8_LDA(At, 1, 0); PG8_STAGE(PG8_SA(0, 1), a2 + hstepA, voffA);
            PG8_WAIT_L(8); PG8_BAR; PG8_WAIT_L(0); PG8_MMA(0, 0, At, B0); PG8_BAR; PG8_SCHED;
            PG8_LDB(B1, 1, 1); PG8_STAGE(PG8_SB(1, 0), b3, voffB);
            PG8_BAR; PG8_WAIT_L(0); PG8_MMA(0, 1, At, B1); PG8_BAR;
            PG8_LDA(At, 1, 1); PG8_STAGE(PG8_SA(1, 0), a3, voffA);
            PG8_BAR; PG8_WAIT_L(0); PG8_MMA(1, 0, At, B0); PG8_BAR; PG8_SCHED;
            PG8_STAGE(PG8_SB(1, 1), b3 + hstepB, voffB);
            PG8_WAIT_V(6); PG8_BAR; PG8_MMA(1, 1, At, B1); PG8_BAR;
            }
        }
        if constexpr (ALIGN_EPI) { if (wr == 0) PG8_BAR; }
        if constexpr (!Epi::AFTER_DRAIN) { E(acc, cur, wr, wc, fr, fq); S.done(cur); }
        if (!has_next) break;
#pragma unroll
        for (int a = 0; a < 2; ++a)
#pragma unroll
            for (int b = 0; b < 2; ++b)
#pragma unroll
                for (int m = 0; m < 4; ++m)
#pragma unroll
                    for (int n = 0; n < 2; ++n) acc[a][b][m][n] = (f32x4){0.f, 0.f, 0.f, 0.f};
        cur = nxt; cA = nA; cB = nB; ++ui;
        if constexpr (ALIGN_EPI) { if (wr == 1) PG8_BAR; }
    }
    PG8_WAIT_V(0);
    if constexpr (!ALIGN_EPI) { if (wr == 0) PG8_BAR; }
    PG8_BAR;
    if constexpr (Epi::AFTER_DRAIN) { E.fused(acc, cur, wr, wc, fr, fq, lds, wid, lane); S.done(cur); }
#undef PG8_SA
#undef PG8_SB
#undef PG8_STAGE
#undef PG8_LDA
#undef PG8_LDB
#undef PG8_MMA
#undef PG8_WAIT_V
#undef PG8_WAIT_L
#undef PG8_BAR
#undef PG8_SCHED
}
}

__device__ __forceinline__ u32x4 pack8(const f32x4 a, const f32x4 b) { u32x4 w; w.x = cvt_pk_bf16(a[0], a[1]); w.y = cvt_pk_bf16(a[2], a[3]); w.z = cvt_pk_bf16(b[0], b[1]); w.w = cvt_pk_bf16(b[2], b[3]); return w; }
__device__ __forceinline__ void unpack8(const u32x4 w, f32x4& a, f32x4& b) {
    a[0] = __uint_as_float(w.x << 16); a[1] = __uint_as_float(w.x & 0xffff0000u); a[2] = __uint_as_float(w.y << 16); a[3] = __uint_as_float(w.y & 0xffff0000u);
    b[0] = __uint_as_float(w.z << 16); b[1] = __uint_as_float(w.z & 0xffff0000u); b[2] = __uint_as_float(w.w << 16); b[3] = __uint_as_float(w.w & 0xffff0000u); }
__device__ __forceinline__ f32x4 silu_mul(const f32x4 g, const f32x4 u) { f32x4 r;
#pragma unroll
    for (int e = 0; e < 4; ++e) r[e] = g[e] * sigmoid_f(g[e]) * u[e];
    return r; }

__device__ __forceinline__ void row_stats4(const float* st, int rowb, int fq, float (&mu)[4], float (&rs)[4]) {
    f32x4 a[4], b[4];
#pragma unroll
    for (int m = 0; m < 4; ++m) { const f32x4* p = (const f32x4*)(st + (size_t)(rowb + m * 16) * 32 + fq * 8); a[m] = p[0]; b[m] = p[1]; }
#pragma unroll
    for (int m = 0; m < 4; ++m) { float s1 = (a[m][0] + a[m][2]) + (b[m][0] + b[m][2]), s2 = (a[m][1] + a[m][3]) + (b[m][1] + b[m][3]);
        s1 = xsum32(xsum16(s1)); s2 = xsum32(xsum16(s2));
        const float mm = s1 * (1.0f / 1024.0f); mu[m] = mm; rs[m] = rsqrtf(fmaxf(s2 * (1.0f / 1024.0f) - mm * mm, 0.f) + LN_EPS_); }
    asm volatile("" ::: "memory");
}
struct EpiSwiglu {
    static constexpr bool PERM = true, AFTER_DRAIN = false, MIDK = false;
    bf16_t* H; const float* st; const float* gW; const float* bW;
    __device__ __forceinline__ void operator()(const f32x4 (&acc)[2][2][4][2], const pg8::Unit& u, int wr, int wc, int fr, int fq) const {
        const int row0 = u.pm * 256 + wr * 64 + fr, cl = wc * 32 + fq * 8, cB0 = u.pn * 256 + cl;
#pragma unroll
        for (int ai = 0; ai < 2; ++ai) { float mu4[4], rs4[4]; row_stats4(st, row0 + ai * 128, fq, mu4, rs4);
#pragma unroll
            for (int m = 0; m < 4; ++m) { const int row = row0 + ai * 128 + m * 16; const float mu = mu4[m], rs = rs4[m];
                f32x4 g0[2], g1[2], b0[2], b1[2];
#pragma unroll
                for (int n = 0; n < 2; ++n) { g0[n] = *(const f32x4*)(gW + cB0 + 4 * n); g1[n] = *(const f32x4*)(gW + cB0 + 128 + 4 * n); b0[n] = *(const f32x4*)(bW + cB0 + 4 * n); b1[n] = *(const f32x4*)(bW + cB0 + 128 + 4 * n); }
                f32x4 h[2];
#pragma unroll
                for (int n = 0; n < 2; ++n) { const f32x4 zg = (acc[ai][0][m][n] - g0[n] * mu) * rs + b0[n], zu = (acc[ai][1][m][n] - g1[n] * mu) * rs + b1[n]; h[n] = silu_mul(zg, zu); }
                *(u32x4*)(H + (size_t)row * FF_ + u.pn * 128 + cl) = pack8(h[0], h[1]); asm volatile("" ::: "memory"); } }
    }
};
struct EpiResid {
    static constexpr bool PERM = true, AFTER_DRAIN = false, MIDK = false;
    const float* Yin; float* Y; bf16_t* Yb; const float* stp; float* stn; const float* g; const float* b; float sc;
    __device__ __forceinline__ void operator()(const f32x4 (&acc)[2][2][4][2], const pg8::Unit& u, int wr, int wc, int fr, int fq) const {
        const int row0 = u.pm * 256 + wr * 64 + fr, col0 = u.pn * 256 + wc * 32 + fq * 8;
#pragma unroll
        for (int ai = 0; ai < 2; ++ai) { float mu4[4], rs4[4]; row_stats4(stp, row0 + ai * 128, fq, mu4, rs4);
#pragma unroll
            for (int m = 0; m < 4; ++m) { const int row = row0 + ai * 128 + m * 16; const float mu = mu4[m], rs = rs4[m];
                float s1 = 0.f, s2 = 0.f;
#pragma unroll
                for (int bj = 0; bj < 2; ++bj) { float* yp = Y + (size_t)row * D_ + col0 + bj * 128; const float* yi = Yin + (size_t)row * D_ + col0 + bj * 128; f32x4 v[2];
#pragma unroll
                    for (int n = 0; n < 2; ++n) { const f32x4 yo = *(const f32x4*)(yi + 4 * n), gvv = *(const f32x4*)(g + col0 + bj * 128 + 4 * n), bvv = *(const f32x4*)(b + col0 + bj * 128 + 4 * n); v[n] = (((yo - mu) * rs) * gvv + bvv) * ALPHA_ + acc[ai][bj][m][n] * sc;
                        *(f32x4*)(yp + 4 * n) = v[n]; s1 += (v[n][0] + v[n][1]) + (v[n][2] + v[n][3]); s2 += (v[n][0] * v[n][0] + v[n][1] * v[n][1]) + (v[n][2] * v[n][2] + v[n][3] * v[n][3]); }
                    *(u32x4*)(Yb + (size_t)row * D_ + col0 + bj * 128) = pack8(v[0], v[1]); }
                s1 = xsum32(xsum16(s1)); s2 = xsum32(xsum16(s2));
                if (fq == 0) *(f32x2*)(stn + (size_t)row * 32 + (u.pn * 4 + wc) * 2) = (f32x2){s1, s2}; asm volatile("" ::: "memory"); } }
    }
};
struct EpiProj {
    static constexpr bool PERM = true, AFTER_DRAIN = false, MIDK = false;
    bf16_t* P; const float* st; const float* gW; const float* bW; const float* cosT; const float* sinT;
    __device__ __forceinline__ void operator()(const f32x4 (&acc)[2][2][4][2], const pg8::Unit& u, int wr, int wc, int fr, int fq) const {
        const int row0 = u.pm * 256 + wr * 64 + fr, cl = wc * 32 + fq * 8, cB0 = u.pn * 256 + cl;
        const bool rope = u.pn < 11, qsc = (u.pn < 2) || (u.pn >= 4 && u.pn < 8);
#pragma unroll
        for (int ai = 0; ai < 2; ++ai) { float mu4[4], rs4[4]; row_stats4(st, row0 + ai * 128, fq, mu4, rs4);
#pragma unroll
          for (int mh = 0; mh < 2; ++mh) { f32x4 cv[2][2], sv[2][2];
            if (rope) {
#pragma unroll
                for (int mm = 0; mm < 2; ++mm)
#pragma unroll
                    for (int n = 0; n < 2; ++n) { const size_t ro = (size_t)(row0 + ai * 128 + (2 * mh + mm) * 16) * 32 + fq * 8 + 4 * n; cv[mm][n] = *(const f32x4*)(cosT + ro); sv[mm][n] = *(const f32x4*)(sinT + ro); } }
#pragma unroll
            for (int mm = 0; mm < 2; ++mm) { const int m = 2 * mh + mm; const int row = row0 + ai * 128 + m * 16; const float mu = mu4[m], rs = rs4[m];
                f32x4 g0[2], g1[2], b0[2], b1[2];
#pragma unroll
                for (int n = 0; n < 2; ++n) { g0[n] = *(const f32x4*)(gW + cB0 + 4 * n); g1[n] = *(const f32x4*)(gW + cB0 + 128 + 4 * n); b0[n] = *(const f32x4*)(bW + cB0 + 4 * n); b1[n] = *(const f32x4*)(bW + cB0 + 128 + 4 * n); }
                f32x4 t1[2], t2[2];
#pragma unroll
                for (int n = 0; n < 2; ++n) { t1[n] = (acc[ai][0][m][n] - g0[n] * mu) * rs + b0[n]; t2[n] = (acc[ai][1][m][n] - g1[n] * mu) * rs + b1[n]; }
                bf16_t* pr = P + (size_t)row * NP_ + u.pn * 256;
                if (rope) { f32x4 o1[2], o2[2];
#pragma unroll
                    for (int n = 0; n < 2; ++n) { const f32x4 c = cv[mm][n], s = sv[mm][n];
                        o1[n] = t1[n] * c - t2[n] * s; o2[n] = t2[n] * c + t1[n] * s; }
                    if (qsc) { o1[0] *= SC2_; o1[1] *= SC2_; o2[0] *= SC2_; o2[1] *= SC2_; }
                    *(u32x4*)(pr + wc * 64 + fq * 8) = pack8(o1[0], o1[1]); *(u32x4*)(pr + wc * 64 + 32 + fq * 8) = pack8(o2[0], o2[1]);
                } else { *(u32x4*)(pr + cl) = pack8(t1[0], t1[1]); *(u32x4*)(pr + 128 + cl) = pack8(t2[0], t2[1]); } asm volatile("" ::: "memory"); } } }
    }
};
struct EpiGate {
    static constexpr bool PERM = true, AFTER_DRAIN = false, MIDK = false;
    bf16_t* G; const float* st; const float* gW; const float* bW;
    __device__ __forceinline__ void operator()(const f32x4 (&acc)[2][2][4][2], const pg8::Unit& u, int wr, int wc, int fr, int fq) const {
        const int row0 = u.pm * 256 + wr * 64 + fr, cl = wc * 32 + fq * 8, cB0 = u.pn * 256 + cl;
#pragma unroll
        for (int ai = 0; ai < 2; ++ai) { float mu4[4], rs4[4]; row_stats4(st, row0 + ai * 128, fq, mu4, rs4);
#pragma unroll
            for (int m = 0; m < 4; ++m) { const int row = row0 + ai * 128 + m * 16; const float mu = mu4[m], rs = rs4[m];
#pragma unroll
                for (int bj = 0; bj < 2; ++bj) { f32x4 z[2];
#pragma unroll
                    for (int n = 0; n < 2; ++n) { z[n] = (acc[ai][bj][m][n] - *(const f32x4*)(gW + cB0 + bj * 128 + 4 * n) * mu) * rs + *(const f32x4*)(bW + cB0 + bj * 128 + 4 * n);
#pragma unroll
                        for (int e = 0; e < 4; ++e) z[n][e] = sigmoid_f(z[n][e]); }
                    *(u32x4*)(G + (size_t)row * NG_ + cB0 + bj * 128) = pack8(z[0], z[1]); } asm volatile("" ::: "memory"); } }
    }
};
struct EpiBranch {
    static constexpr bool PERM = true, AFTER_DRAIN = false, MIDK = true;
    const bf16_t* G; bf16_t* Mg;
    __device__ __forceinline__ void mid(f32x4 (&acc)[2][2][4][2], const pg8::Unit& u, int t, int wr, int wc, int fr, int fq) const {
        const int brd = (t >> 3) - 1;
        int fr_ = fr; asm volatile("" : "+v"(fr_));
        const int row0 = u.pm * 256 + wr * 64 + fr_, col0 = u.pn * 256 + wc * 32 + fq * 8;
#pragma unroll
        for (int ai = 0; ai < 2; ++ai)
#pragma unroll
            for (int m = 0; m < 4; ++m) { const bf16_t* gp = G + (size_t)(row0 + ai * 128 + m * 16) * NG_ + brd * 1024 + col0;
#pragma unroll
                for (int bj = 0; bj < 2; ++bj)
#pragma unroll
                    for (int n = 0; n < 2; ++n) { const u32x2 x = *(const u32x2*)(gp + bj * 128 + 4 * n), y = *(const u32x2*)(gp + 1024 + bj * 128 + 4 * n);
                        acc[ai][bj][m][n][0] *= __uint_as_float(x.x << 16) * fast_rcp(fmaxf(__uint_as_float(y.x << 16), 1e-30f)); acc[ai][bj][m][n][1] *= __uint_as_float(x.x & 0xffff0000u) * fast_rcp(fmaxf(__uint_as_float(y.x & 0xffff0000u), 1e-30f));
                        acc[ai][bj][m][n][2] *= __uint_as_float(x.y << 16) * fast_rcp(fmaxf(__uint_as_float(y.y << 16), 1e-30f)); acc[ai][bj][m][n][3] *= __uint_as_float(x.y & 0xffff0000u) * fast_rcp(fmaxf(__uint_as_float(y.y & 0xffff0000u), 1e-30f));
                        asm volatile("" ::: "memory"); } }
    }
    __device__ __forceinline__ void operator()(const f32x4 (&acc)[2][2][4][2], const pg8::Unit& u, int wr, int wc, int fr, int fq) const {
        const int row0 = u.pm * 256 + wr * 64 + fr, col0 = u.pn * 256 + wc * 32 + fq * 8;
#pragma unroll
        for (int ai = 0; ai < 2; ++ai)
#pragma unroll
            for (int m = 0; m < 4; ++m) { const int row = row0 + ai * 128 + m * 16;
#pragma unroll
                for (int bj = 0; bj < 2; ++bj) { f32x4 ga, gb; unpack8(*(const u32x4*)(G + (size_t)row * NG_ + 2048 + col0 + bj * 128), ga, gb);
                    *(u32x4*)(Mg + (size_t)row * D_ + col0 + bj * 128) = pack8(ga * acc[ai][bj][m][0], gb * acc[ai][bj][m][1]); }
                asm volatile("" ::: "memory"); }
    }
};

#ifndef DSA1_REPS
#define DSA1_REPS 1
#endif
#ifndef DSA3_REPS
#define DSA3_REPS 1
#endif
#define MFMA16(a, b, c) __builtin_amdgcn_mfma_f32_16x16x32_bf16((a), (b), (c), 0, 0, 0)
typedef short v4i16_t __attribute__((ext_vector_type(4)));
__device__ __forceinline__ s16x4 tr_read(LAS unsigned char* p) { return __builtin_bit_cast(s16x4, __builtin_amdgcn_ds_read_tr16_b64_v4i16((LAS v4i16_t*)p)); }
struct KVRegs { bf16x8 ka[2], kb[2]; u32x4 v[4]; };
__device__ __forceinline__ void kv_load(KVRegs& r, const bf16_t* kbase, size_t kst, const bf16_t* vbase, int s, int lane) {
    const int li = lane & 15, g4 = lane >> 4;
    const bf16_t* k0 = kbase + (size_t)(32 * s + li) * kst + 8 * g4;
    r.ka[0] = *(const bf16x8*)k0; r.ka[1] = *(const bf16x8*)(k0 + 32);
    const bf16_t* k1 = k0 + 16 * kst;
    r.kb[0] = *(const bf16x8*)k1; r.kb[1] = *(const bf16x8*)(k1 + 32);
    const bf16_t* vp = vbase + (size_t)(32 * s + (lane >> 1)) * kst + (lane & 1) * 32;
#pragma unroll
    for (int i = 0; i < 4; ++i) r.v[i] = *(const u32x4*)(vp + 8 * i);
}
struct BandMask { int k0, iq, W; __device__ __forceinline__ float operator()(int ko, float s) const { return ((unsigned)(iq - (k0 + ko)) <= (unsigned)W) ? s : -INFINITY; } };
struct SelMask { unsigned w; __device__ __forceinline__ float operator()(int ko, float s) const { const int mk = (int)(w << (31 - ko)) >> 31; return __uint_as_float((__float_as_uint(s) & (unsigned)mk) | (0xff800000u & ~(unsigned)mk)); } };
template <class MaskF>
__device__ __forceinline__ void attn_step(const KVRegs& r, const bf16x8 (&bq)[2], LAS unsigned char* vl, int lane, const MaskF mask, float& m, float& l, f32x4 (&o)[4]) {
    const int g4 = lane >> 4;
    { LAS unsigned char* wp = vl + (lane >> 1) * 128 + (lane & 1) * 64;
#pragma unroll
      for (int i = 0; i < 4; ++i) *(LAS u32x4*)(wp + 16 * i) = r.v[i]; }
    f32x4 sa = (f32x4){0.f, 0.f, 0.f, 0.f}, sb = (f32x4){0.f, 0.f, 0.f, 0.f};
    sa = MFMA16(r.ka[0], bq[0], sa); sa = MFMA16(r.ka[1], bq[1], sa);
    sb = MFMA16(r.kb[0], bq[0], sb); sb = MFMA16(r.kb[1], bq[1], sb);
    float x[8];
#pragma unroll
    for (int e = 0; e < 4; ++e) { x[e] = mask(4 * g4 + e, sa[e]); x[4 + e] = mask(16 + 4 * g4 + e, sb[e]); }
    float tm = fmaxf(fmaxf(fmaxf(x[0], x[1]), fmaxf(x[2], x[3])), fmaxf(fmaxf(x[4], x[5]), fmaxf(x[6], x[7])));
    tm = xmax32(xmax16(tm));
    const float mn = fmaxf(m, tm);
    if (__ballot(mn > m)) { const float al = fast_exp2(m - mn); l *= al;
#pragma unroll
        for (int db = 0; db < 4; ++db) o[db] = o[db] * al; }
    m = mn;
    float p[8], ps = 0.f;
#pragma unroll
    for (int e = 0; e < 8; ++e) { p[e] = fast_exp2(x[e] - mn); ps += p[e]; }
    l += ps;
    u32x4 pw; pw.x = cvt_pk_bf16(p[0], p[1]); pw.y = cvt_pk_bf16(p[2], p[3]); pw.z = cvt_pk_bf16(p[4], p[5]); pw.w = cvt_pk_bf16(p[6], p[7]);
    const bf16x8 pf = __builtin_bit_cast(bf16x8, pw);
    asm volatile("s_waitcnt lgkmcnt(0)" ::: "memory");
    LAS unsigned char* rd = vl + (4 * g4 + ((lane & 15) >> 2)) * 128 + (lane & 3) * 8;
#pragma unroll
    for (int db = 0; db < 4; ++db) { const s16x4 t0 = tr_read(rd + db * 32), t1 = tr_read(rd + 16 * 128 + db * 32);
        const bf16x8 vf = (bf16x8){t0[0], t0[1], t0[2], t0[3], t1[0], t1[1], t1[2], t1[3]};
        o[db] = MFMA16(vf, pf, o[db]); }
    asm volatile("s_waitcnt lgkmcnt(0)" ::: "memory");
}
__device__ __forceinline__ void attn_store(const f32x4 (&o)[4], float inv, bf16_t* op, int g4) {
#pragma unroll
    for (int db = 0; db < 4; ++db) { u32x2 w; w.x = cvt_pk_bf16(o[db][0] * inv, o[db][1] * inv); w.y = cvt_pk_bf16(o[db][2] * inv, o[db][3] * inv); *(u32x2*)(op + 16 * db + 4 * g4) = w; }
}
struct BandGen { int iq, W; __device__ __forceinline__ BandMask operator()(int s) const { return BandMask{32 * s, iq, W}; } };
struct SelGen { const LAS unsigned char* row; __device__ __forceinline__ SelMask operator()(int s) const { return SelMask{*(const LAS unsigned*)(row + 4 * s)}; } };
template <class Gen>
__device__ __forceinline__ void attn_loop(const bf16_t* kbase, size_t kst, const bf16_t* vbase, int s_lo, int s_hi, const bf16x8 (&bq)[2], LAS unsigned char* vl, int lane, const Gen gen, float& m, float& l, f32x4 (&o)[4]) {
    KVRegs kv[4];
    kv_load(kv[0], kbase, kst, vbase, s_lo, lane);
    if (s_lo + 1 <= s_hi) kv_load(kv[1], kbase, kst, vbase, s_lo + 1, lane);
    if (s_lo + 2 <= s_hi) kv_load(kv[2], kbase, kst, vbase, s_lo + 2, lane);
    for (int s = s_lo; s <= s_hi; s += 4) {
#pragma unroll
        for (int j = 0; j < 4; ++j) {
            if (s + j <= s_hi) {
                if (s + j + 3 <= s_hi) kv_load(kv[(j + 3) & 3], kbase, kst, vbase, s + j + 3, lane);
                attn_step(kv[j], bq, vl, lane, gen(s + j), m, l, o);
            }
        }
    }
}
template <int NQ>
__device__ __forceinline__ void band_step(const KVRegs& r, const bf16x8 (&bq)[NQ][2], LAS unsigned char* vl, int lane, int s, int q0, int W, float (&m)[NQ], float (&l)[NQ], f32x4 (&o)[NQ][4]) {
    const int g4 = lane >> 4, qi = lane & 15;
    { LAS unsigned char* wp = vl + (lane >> 1) * 128 + (lane & 1) * 64;
#pragma unroll
      for (int i = 0; i < 4; ++i) *(LAS u32x4*)(wp + 16 * i) = r.v[i]; }
    asm volatile("s_waitcnt lgkmcnt(0)" ::: "memory");
    bf16x8 vf[4];
    { LAS unsigned char* rd = vl + (4 * g4 + (qi >> 2)) * 128 + (lane & 3) * 8;
#pragma unroll
      for (int db = 0; db < 4; ++db) { const s16x4 t0 = tr_read(rd + db * 32), t1 = tr_read(rd + 16 * 128 + db * 32);
          vf[db] = (bf16x8){t0[0], t0[1], t0[2], t0[3], t1[0], t1[1], t1[2], t1[3]}; } }
#pragma unroll
    for (int g = 0; g < NQ; ++g) {
        const int qlo = q0 + 16 * g;
        if (32 * s <= qlo + 15 && 32 * s + 31 >= qlo - W) {
            f32x4 sa = (f32x4){0.f, 0.f, 0.f, 0.f}, sb = (f32x4){0.f, 0.f, 0.f, 0.f};
            sa = MFMA16(r.ka[0], bq[g][0], sa); sa = MFMA16(r.ka[1], bq[g][1], sa);
            sb = MFMA16(r.kb[0], bq[g][0], sb); sb = MFMA16(r.kb[1], bq[g][1], sb);
            const BandMask mask{32 * s, qlo + qi, W};
            float x[8];
#pragma unroll
            for (int e = 0; e < 4; ++e) { x[e] = mask(4 * g4 + e, sa[e]); x[4 + e] = mask(16 + 4 * g4 + e, sb[e]); }
            float tm = fmaxf(fmaxf(fmaxf(x[0], x[1]), fmaxf(x[2], x[3])), fmaxf(fmaxf(x[4], x[5]), fmaxf(x[6], x[7])));
            tm = xmax32(xmax16(tm));
            const float mn = fmaxf(m[g], tm);
            if (__ballot(mn > m[g])) { const float al = fast_exp2(m[g] - mn); l[g] *= al;
#pragma unroll
                for (int db = 0; db < 4; ++db) o[g][db] = o[g][db] * al; }
            m[g] = mn;
            float pp[8], ps = 0.f;
#pragma unroll
            for (int e = 0; e < 8; ++e) { pp[e] = fast_exp2(x[e] - mn); ps += pp[e]; }
            l[g] += ps;
            u32x4 pw; pw.x = cvt_pk_bf16(pp[0], pp[1]); pw.y = cvt_pk_bf16(pp[2], pp[3]); pw.z = cvt_pk_bf16(pp[4], pp[5]); pw.w = cvt_pk_bf16(pp[6], pp[7]);
            const bf16x8 pf = __builtin_bit_cast(bf16x8, pw);
#pragma unroll
            for (int db = 0; db < 4; ++db) o[g][db] = MFMA16(vf[db], pf, o[g][db]);
        }
    }
}
template <int NQ>
__device__ __forceinline__ void band_unit(int u, const bf16_t* P, bf16_t* OB, bf16_t* ACX, float* LSE, const float* sink, LAS unsigned char* vl, int lane_in) {
    int lane = lane_in; asm volatile("" : "+v"(lane));
    constexpr int UQ = 16 * NQ, TPS = SEQ_ / UQ, UPC = NB_ * 8 * TPS;
    static_assert(UPC == 4096, "unit order below assumes 64-query units");
    const int q_ = u >> 11, cfg = q_ & 3, rr = (u & 2047) + 2048 * (q_ >> 2), b = rr / (8 * TPS), h = (rr / TPS) & 7, ts = rr % TPS;
    const int d = (cfg == 1) ? 4 : (cfg == 2) ? 16 : 1, tpc = TPS / d, cls = ts / tpc, it = ts % tpc, q0 = UQ * it, W = (cfg == 3) ? 127 : 128;
    const int qcol = (cfg < 3) ? PC_QA + h * 64 : PC_QB + h * 64, kcol = (cfg < 3) ? PC_KA + h * 64 : PC_KB + (h >> 2) * 64, vcol = (cfg < 3) ? PC_VA + h * 64 : PC_VB + (h >> 2) * 64;
    const size_t rowbase = (size_t)b * SEQ_ + cls, kst = (size_t)d * NP_;
    const bf16_t* kbase = P + rowbase * NP_ + kcol; const bf16_t* vbase = P + rowbase * NP_ + vcol;
    const int qi = lane & 15, g4 = lane >> 4;
    bf16x8 bq[NQ][2]; float m[NQ], l[NQ]; f32x4 o[NQ][4];
#pragma unroll
    for (int g = 0; g < NQ; ++g) { const bf16_t* qp = P + (rowbase + (size_t)d * (q0 + 16 * g + qi)) * NP_ + qcol + 8 * g4; bq[g][0] = *(const bf16x8*)qp; bq[g][1] = *(const bf16x8*)(qp + 32);
        m[g] = -1e30f; l[g] = 0.f; if (cfg == 3) { m[g] = sink[h] * 1.4426950408889634f; l[g] = (g4 == 0) ? 1.f : 0.f; }
#pragma unroll
        for (int db = 0; db < 4; ++db) o[g][db] = (f32x4){0.f, 0.f, 0.f, 0.f}; }
    const int s_hi = (q0 + UQ - 1) >> 5, s_lo = (q0 >= 128) ? ((q0 - 128) >> 5) : 0;
    constexpr int RING = (NQ > 2) ? 2 : 3;
    KVRegs kv[RING];
    kv_load(kv[0], kbase, kst, vbase, s_lo, lane);
    if (RING > 2 && s_lo + 1 <= s_hi) kv_load(kv[1], kbase, kst, vbase, s_lo + 1, lane);
    for (int s = s_lo; s <= s_hi; s += RING) {
#pragma unroll
        for (int j = 0; j < RING; ++j) {
            if (s + j <= s_hi) {
                if (s + j + RING - 1 <= s_hi) kv_load(kv[(j + RING - 1) % RING], kbase, kst, vbase, s + j + RING - 1, lane);
                band_step<NQ>(kv[j], bq, vl, lane, s + j, q0, W, m, l, o);
            }
        }
    }
#pragma unroll
    for (int g = 0; g < NQ; ++g) {
        const size_t tq = rowbase + (size_t)d * (q0 + 16 * g + qi);
        float lt = l[g]; lt = xsum32(xsum16(lt));
        bf16_t* op = (cfg == 0) ? OB + tq * NO_ + h * 64 : (cfg == 3) ? OB + tq * NO_ + 512 + h * 64 : ACX + (size_t)(cfg - 1) * T_ * 512 + tq * 512 + h * 64;
        attn_store(o[g], fast_rcp(lt), op, g4);
        if (cfg < 3 && g4 == 0) LSE[(size_t)cfg * T_ * 8 + tq * 8 + h] = m[g] + __log2f(lt);
    }
}
template <class MaskF>
__device__ __forceinline__ void attn_step_lds(const LAS unsigned char* kl, LAS unsigned char* vl, const bf16x8 (&bq)[2], int lane, const MaskF mask, float& m, float& l, f32x4 (&o)[4]) {
    const int g4 = lane >> 4, li = lane & 15;
    const LAS unsigned char* kp = kl + li * 144 + 16 * g4;
    const bf16x8 ka0 = *(const LAS bf16x8*)kp, ka1 = *(const LAS bf16x8*)(kp + 64), kb0 = *(const LAS bf16x8*)(kp + 16 * 144), kb1 = *(const LAS bf16x8*)(kp + 16 * 144 + 64);
    f32x4 sa = (f32x4){0.f, 0.f, 0.f, 0.f}, sb = (f32x4){0.f, 0.f, 0.f, 0.f};
    sa = MFMA16(ka0, bq[0], sa); sa = MFMA16(ka1, bq[1], sa);
    sb = MFMA16(kb0, bq[0], sb); sb = MFMA16(kb1, bq[1], sb);
    LAS unsigned char* rd = vl + (4 * g4 + (li >> 2)) * 128 + (lane & 3) * 8;
    s16x4 t0[4], t1[4];
#pragma unroll
    for (int db = 0; db < 4; ++db) { t0[db] = tr_read(rd + db * 32); t1[db] = tr_read(rd + 16 * 128 + db * 32); }
    float x[8];
#pragma unroll
    for (int e = 0; e < 4; ++e) { x[e] = mask(4 * g4 + e, sa[e]); x[4 + e] = mask(16 + 4 * g4 + e, sb[e]); }
    float tm = fmaxf(fmaxf(fmaxf(x[0], x[1]), fmaxf(x[2], x[3])), fmaxf(fmaxf(x[4], x[5]), fmaxf(x[6], x[7])));
    tm = xmax32(xmax16(tm));
    const float mn = fmaxf(m, tm);
    if (__ballot(mn > m)) { const float al = fast_exp2(m - mn); l *= al;
#pragma unroll
        for (int db = 0; db < 4; ++db) o[db] = o[db] * al; }
    m = mn;
    float p[8], ps = 0.f;
#pragma unroll
    for (int e = 0; e < 8; ++e) { p[e] = fast_exp2(x[e] - mn); ps += p[e]; }
    l += ps;
    u32x4 pw; pw.x = cvt_pk_bf16(p[0], p[1]); pw.y = cvt_pk_bf16(p[2], p[3]); pw.z = cvt_pk_bf16(p[4], p[5]); pw.w = cvt_pk_bf16(p[6], p[7]);
    const bf16x8 pf = __builtin_bit_cast(bf16x8, pw);
#pragma unroll
    for (int db = 0; db < 4; ++db) { const bf16x8 vf = (bf16x8){t0[db][0], t0[db][1], t0[db][2], t0[db][3], t1[db][0], t1[db][1], t1[db][2], t1[db][3]};
        o[db] = MFMA16(vf, pf, o[db]); }
}
constexpr int C_SCW = 4112, C_IDX = 16 * C_SCW, C_CNT = C_IDX + 16 * 512, C_VT = C_CNT + 64, C_VST = 0, C_LDS_END = C_VT + 8 * 4096;
__device__ __forceinline__ unsigned f16key(unsigned h) { return (h & 0x8000u) ? (~h & 0xffffu) : (h | 0x8000u); }
__device__ __forceinline__ unsigned wave_sum_u32(unsigned c) {
    c += (unsigned)__builtin_amdgcn_update_dpp(0, (int)c, 0x128, 0xf, 0xf, false);
    c += (unsigned)__builtin_amdgcn_update_dpp(0, (int)c, 0x124, 0xf, 0xf, false);
    c += (unsigned)__builtin_amdgcn_update_dpp(0, (int)c, 0x122, 0xf, 0xf, false);
    c += (unsigned)__builtin_amdgcn_update_dpp(0, (int)c, 0x121, 0xf, 0xf, false);
    { const auto r = __builtin_amdgcn_permlane16_swap(c, c, false, false); c = r[0] + r[1]; }
    { const auto r = __builtin_amdgcn_permlane32_swap(c, c, false, false); c = r[0] + r[1]; }
    return c;
}
template <int NJ>
__device__ __forceinline__ void dsa_select(LAS unsigned char* lds, int qs, int t, int lane) {
    unsigned v[NJ];
#pragma unroll
    for (int j = 0; j < NJ; ++j) { const int key = 64 * j + lane; const unsigned raw = *(const LAS unsigned short*)(lds + qs * C_SCW + key * 2); v[j] = (key <= t) ? f16key(raw) : 0u; }
    unsigned theta = 1u; int need = t + 1;
    if (t + 1 > 256) {
        need = 256; theta = 0u;
        for (int bit = 15; bit >= 0; --bit) { const unsigned tr = theta | (1u << bit); unsigned c = 0u;
#pragma unroll
            for (int j = 0; j < NJ; ++j) c += (v[j] >= tr) ? 1u : 0u;
            c = wave_sum_u32(c);
            theta = (c >= 256u) ? tr : theta; }
        theta = (unsigned)__builtin_amdgcn_readfirstlane((int)theta);
    }
    int cgt = 0;
#pragma unroll
    for (int j = 0; j < NJ; ++j) cgt += __popcll(__ballot(v[j] > theta));
    const int rem = need - cgt; int taken = 0, base = 0;
    LAS unsigned short* il = (LAS unsigned short*)(lds + C_IDX + qs * 512);
#pragma unroll
    for (int j = 0; j < NJ; ++j) {
        const bool eq = (v[j] == theta);
        const unsigned long long tmask = __ballot(eq);
        const int rank = (int)__builtin_amdgcn_mbcnt_hi((unsigned)(tmask >> 32), __builtin_amdgcn_mbcnt_lo((unsigned)tmask, 0u)) + taken;
        const bool sel = (v[j] > theta) || (eq && rank < rem);
        const unsigned long long smask = __ballot(sel);
        taken += __popcll(tmask);
        const int pos = base + (int)__builtin_amdgcn_mbcnt_hi((unsigned)(smask >> 32), __builtin_amdgcn_mbcnt_lo((unsigned)smask, 0u));
        if (sel) il[pos] = (unsigned short)(64 * j + lane);
        base += __popcll(smask);
    }
#pragma unroll
    for (int i = 0; i < 4; ++i) { const int pos = base + lane + 64 * i; if (pos < 256) il[pos] = 0; }
    if (lane == 0) *(LAS int*)(lds + C_CNT + qs * 4) = base;
}
struct CountMask { int s32, cnt; __device__ __forceinline__ float operator()(int ko, float s) const { return (s32 + ko < cnt) ? s : -INFINITY; } };
__device__ __forceinline__ void kv_gather(KVRegs& r, const bf16_t* Pb, const LAS unsigned short* il, int s, int lane) {
    const int li = lane & 15, g4 = lane >> 4;
    const unsigned ra = il[32 * s + li], rb = il[32 * s + 16 + li], rv = il[32 * s + (lane >> 1)];
    const bf16_t* k0 = Pb + (size_t)ra * NP_ + PC_KC + 8 * g4; const bf16_t* k1 = Pb + (size_t)rb * NP_ + PC_KC + 8 * g4;
    r.ka[0] = *(const bf16x8*)k0; r.ka[1] = *(const bf16x8*)(k0 + 32); r.kb[0] = *(const bf16x8*)k1; r.kb[1] = *(const bf16x8*)(k1 + 32);
    const bf16_t* vp = Pb + (size_t)rv * NP_ + PC_VC + (lane & 1) * 32;
#pragma unroll
    for (int i = 0; i < 4; ++i) r.v[i] = *(const u32x4*)(vp + 8 * i);
}
__device__ __forceinline__ void dsa_unit(int b, int blk, const bf16_t* P, bf16_t* OB, LAS unsigned char* lds, int wave, int tid_in) {
    int tid = tid_in; asm volatile("" : "+v"(tid));
    const int lane = tid & 63;
    const int t0 = blk * 16, nk = t0 + 16; const size_t tok0 = (size_t)b * SEQ_;
    const int qi = lane & 15, g4 = lane >> 4;
    const bf16_t* qrow = P + (tok0 + t0 + qi) * NP_;
    {
        bf16x8 bqi[8][2]; float w[8];
#pragma unroll
        for (int h = 0; h < 8; ++h) { bqi[h][0] = *(const bf16x8*)(qrow + PC_QI + h * 64 + 8 * g4); bqi[h][1] = *(const bf16x8*)(qrow + PC_QI + h * 64 + 32 + 8 * g4); }
        { const u32x4 ww = *(const u32x4*)(qrow + PC_WI); f32x4 wa, wb; unpack8(ww, wa, wb);
#pragma unroll
          for (int e = 0; e < 4; ++e) { w[e] = wa[e]; w[4 + e] = wb[e]; } }
        const int ntile = nk >> 4;
        const bf16_t* kp0 = P + (tok0 + qi) * NP_ + PC_KI + 8 * g4;
        bf16x8 kf[6][2];
#pragma unroll
        for (int i = 0; i < 5; ++i) if (wave + 8 * i < ntile) { const bf16_t* kp = kp0 + (size_t)(16 * (wave + 8 * i)) * NP_; kf[i][0] = *(const bf16x8*)kp; kf[i][1] = *(const bf16x8*)(kp + 32); }
        for (int kt = wave; kt < ntile; kt += 48) {
#pragma unroll
            for (int j = 0; j < 6; ++j) {
                const int kc = kt + 8 * j;
                if (kc < ntile) {
                    if (kc + 40 < ntile) { const bf16_t* kp = kp0 + (size_t)(16 * (kc + 40)) * NP_; kf[(j + 5) % 6][0] = *(const bf16x8*)kp; kf[(j + 5) % 6][1] = *(const bf16x8*)(kp + 32); }
                    f32x4 sc = (f32x4){0.f, 0.f, 0.f, 0.f};
#pragma unroll
                    for (int h = 0; h < 8; ++h) { f32x4 s = (f32x4){0.f, 0.f, 0.f, 0.f}; s = MFMA16(kf[j][0], bqi[h][0], s); s = MFMA16(kf[j][1], bqi[h][1], s);
#pragma unroll
                        for (int e = 0; e < 4; ++e) sc[e] = fmaf(w[h], fmaxf(s[e], 0.f), sc[e]); }
                    u32x2 o2;
                    { const _Float16 h0 = (_Float16)sc[0], h1 = (_Float16)sc[1], h2 = (_Float16)sc[2], h3 = (_Float16)sc[3];
                      o2.x = (unsigned)__builtin_bit_cast(unsigned short, h0) | ((unsigned)__builtin_bit_cast(unsigned short, h1) << 16);
                      o2.y = (unsigned)__builtin_bit_cast(unsigned short, h2) | ((unsigned)__builtin_bit_cast(unsigned short, h3) << 16); }
                    *(LAS u32x2*)(lds + qi * C_SCW + (16 * kc + 4 * g4) * 2) = o2;
                }
            }
        }
    }
    __syncthreads();
    {
        const int nj = (nk + 63) >> 6;
        for (int qq = 0; qq < 2; ++qq) {
            const int qs = wave * 2 + qq, t = t0 + qs;
            if (nj <= 8) dsa_select<8>(lds, qs, t, lane); else if (nj <= 16) dsa_select<16>(lds, qs, t, lane); else if (nj <= 24) dsa_select<24>(lds, qs, t, lane); else dsa_select<32>(lds, qs, t, lane);
        }
    }
    __syncthreads();
    {
        const bf16_t* Pb = P + tok0 * NP_;
        LAS unsigned char* vl = lds + C_VT + wave * 4096;
        const int col = lane & 15;
        for (int qq = 0; qq < 2; ++qq) {
            const int qs = wave * 2 + qq;
            const LAS unsigned short* il = (const LAS unsigned short*)(lds + C_IDX + qs * 512);
            const int cnt = *(const LAS int*)(lds + C_CNT + qs * 4);
            bf16x8 bq[2];
            { const bf16_t* qp = P + (tok0 + t0 + qs) * NP_ + PC_QC + (col & 7) * 64 + 8 * g4; bq[0] = *(const bf16x8*)qp; bq[1] = *(const bf16x8*)(qp + 32);
              if (col >= 8) { bq[0] = (bf16x8){0, 0, 0, 0, 0, 0, 0, 0}; bq[1] = bq[0]; } }
            float m = -1e30f, l = 0.f; f32x4 o[4];
#pragma unroll
            for (int db = 0; db < 4; ++db) o[db] = (f32x4){0.f, 0.f, 0.f, 0.f};
            const int s_hi = ((cnt + 31) >> 5) - 1;
            KVRegs kv[2];
            kv_gather(kv[0], Pb, il, 0, lane);
            for (int s = 0; s <= s_hi; s += 2) {
#pragma unroll
                for (int j = 0; j < 2; ++j) {
                    if (s + j <= s_hi) {
                        if (s + j + 1 <= s_hi) kv_gather(kv[(j + 1) % 2], Pb, il, s + j + 1, lane);
                        attn_step(kv[j], bq, vl, lane, CountMask{32 * (s + j), cnt}, m, l, o);
                    }
                }
            }
            float lt = l; lt = xsum32(xsum16(lt));
            if (col < 8) attn_store(o, fast_rcp(lt), OB + (tok0 + t0 + qs) * NO_ + 1024 + col * 64, g4);
        }
    }
    __syncthreads();
}

__device__ __forceinline__ void prep_load(f32x4 (&r)[8], const float* W, int N_src, int k0, int src_col, bool cv, int lane) {
    const float* p = W + (size_t)(k0 + (lane >> 3)) * N_src + src_col + 4 * (lane & 7);
#pragma unroll
    for (int i = 0; i < 8; ++i) r[i] = cv ? *(const f32x4*)(p + (size_t)(8 * i) * N_src) : (f32x4){0.f, 0.f, 0.f, 0.f};
}
__device__ __forceinline__ void prep_chunk(const f32x4 (&r)[8], int k0, int ldd, const float* g, const float* b, bf16_t* dst, LAS float* scr, int lane, f32x4& sg, f32x4& sb) {
    const int c4 = lane & 7, r8 = lane >> 3;
#pragma unroll
    for (int i = 0; i < 8; ++i) { const int row = r8 + 8 * i; const float gv = g ? g[k0 + row] : 1.f, bv = b ? b[k0 + row] : 0.f; f32x4 wr;
#pragma unroll
        for (int e = 0; e < 4; ++e) { wr[e] = bf2f(f2bf(r[i][e] * gv)); scr[row * 33 + 4 * c4 + e] = wr[e]; }
        sg += wr; sb += r[i] * bv; }
    asm volatile("s_waitcnt lgkmcnt(0)" ::: "memory");
    const int c = lane & 7;
#pragma unroll
    for (int j = 0; j < 4; ++j) { const int nn = (lane >> 3) + 8 * j; const LAS float* s = scr + (8 * c) * 33 + nn;
        u32x4 o; o.x = (f2bf(s[0]) | (f2bf(s[33]) << 16)); o.y = (f2bf(s[66]) | (f2bf(s[99]) << 16)); o.z = (f2bf(s[132]) | (f2bf(s[165]) << 16)); o.w = (f2bf(s[198]) | (f2bf(s[231]) << 16));
        *(u32x4*)(dst + (size_t)nn * ldd + k0 + 8 * c) = o; }
    asm volatile("s_waitcnt lgkmcnt(0)" ::: "memory");
}
__device__ __forceinline__ void prep_item(const float* W, int N_src, int ldd, int kbeg, int kend, int src_col, int nvalid, const float* g, const float* b, bf16_t* dst, float* gWo, float* bWo, LAS float* scr, int lane_in) {
    int lane = lane_in; asm volatile("" : "+v"(lane));
    const bool cv = 4 * (lane & 7) < nvalid;
    f32x4 sg = (f32x4){0.f, 0.f, 0.f, 0.f}, sb = (f32x4){0.f, 0.f, 0.f, 0.f};
    f32x4 ra[8], rb[8];
    prep_load(ra, W, N_src, kbeg, src_col, cv, lane);
    for (int k0 = kbeg; k0 < kend; k0 += 128) {
        if (k0 + 64 < kend) prep_load(rb, W, N_src, k0 + 64, src_col, cv, lane);
        prep_chunk(ra, k0, ldd, g, b, dst, scr, lane, sg, sb);
        if (k0 + 64 < kend) {
            if (k0 + 128 < kend) prep_load(ra, W, N_src, k0 + 128, src_col, cv, lane);
            prep_chunk(rb, k0 + 64, ldd, g, b, dst, scr, lane, sg, sb);
        }
    }
    if (gWo) {
#pragma unroll
        for (int e = 0; e < 4; ++e) { sg[e] += __shfl_xor(sg[e], 8); sg[e] += __shfl_xor(sg[e], 16); sg[e] += __shfl_xor(sg[e], 32); sb[e] += __shfl_xor(sb[e], 8); sb[e] += __shfl_xor(sb[e], 16); sb[e] += __shfl_xor(sb[e], 32); }
        if (lane < 8) { *(f32x4*)(gWo + 4 * lane) = sg; *(f32x4*)(bWo + 4 * lane) = sb; }
    }
}
__device__ __forceinline__ int proj_src(int G, int& nvalid) {
    const int pn = G >> 3, gi = G & 7; nvalid = 32;
    if (pn < 11) { const int bj = gi >> 2, wc = gi & 3; int hb;
        if (pn < 2) hb = SC_QA + (4 * pn + wc) * 64; else if (pn < 4) hb = SC_KA + (4 * (pn - 2) + wc) * 64; else if (pn < 6) hb = SC_QB + (4 * (pn - 4) + wc) * 64;
        else if (pn < 8) hb = SC_QC + (4 * (pn - 6) + wc) * 64; else if (pn < 10) hb = SC_QI + (4 * (pn - 8) + wc) * 64;
        else hb = (wc == 0) ? SC_KB : (wc == 1) ? SC_KB + 64 : (wc == 2) ? SC_KC : SC_KI;
        return hb + 32 * bj; }
    if (pn < 13) return SC_VA + (pn - 11) * 256 + 32 * gi;
    if (gi < 4) return SC_VB + 32 * gi;
    if (gi < 6) return SC_VC + 32 * (gi - 4);
    if (gi == 6) { nvalid = 8; return SC_WI; }
    nvalid = 0; return 0;
}
constexpr int PREP_ITEMS = 176 + 128 + 112 + 96 + 96 + 32 + 176 + 128;
struct Ptrs {
    const float *x, *w_in, *sink, *w_out, *f1i, *f1o, *f2i, *f2o, *lng, *lnb; const int* pos;
    float *Y, *stats, *cosT, *sinT, *ones, *zeros, *aux, *LSE; bf16_t *Yb, *Wb, *BIG, *OB, *ACX;
};
__device__ __forceinline__ void prep_layer(const Ptrs& p, const float* const* inp, int l, LAS unsigned char* lds, int gw, int ngw, int wave, int lane) {
    LAS float* scr = (LAS float*)(lds + wave * 8448);
    const float* g_prev = (l == 0) ? nullptr : p.lng + (size_t)((l - 1) * 3 + 2) * D_; const float* b_prev = (l == 0) ? nullptr : p.lnb + (size_t)((l - 1) * 3 + 2) * D_;
    const float* g0 = p.lng + (size_t)(l * 3 + 0) * D_; const float* b0 = p.lnb + (size_t)(l * 3 + 0) * D_;
    const float* g1 = p.lng + (size_t)(l * 3 + 1) * D_; const float* b1 = p.lnb + (size_t)(l * 3 + 1) * D_;
    for (int it = gw; it < PREP_ITEMS; it += ngw) {
        int r = it;
        const float* W; int N_src, K, kbeg = 0, kend, src, nv = 32; const float* g = nullptr; const float* b = nullptr; bf16_t* dst; float* gWo = nullptr; float* bWo = nullptr;
        if (r < 176) { const int j = r >> 3, gi = r & 7; src = (gi < 4) ? 128 * j + 32 * gi : FF_ + 128 * j + 32 * (gi - 4);
            W = p.f1i + (size_t)l * D_ * 2 * FF_; N_src = 2 * FF_; K = D_; kend = D_; g = g_prev; b = b_prev; dst = p.Wb + WE_1 + (size_t)r * 32 * D_; gWo = p.aux + AUX_G1 + r * 32; bWo = p.aux + AUX_B1 + r * 32; }
        else if ((r -= 176) < 128) { const int rg = r >> 2, kq = r & 3; W = p.f1o + (size_t)l * FF_ * D_; N_src = D_; K = FF_; kbeg = 704 * kq; kend = kbeg + 704; src = 32 * rg; dst = p.Wb + WE_2 + (size_t)rg * 32 * FF_; }
        else if ((r -= 128) < 112) { src = proj_src(r, nv); W = p.w_in + (size_t)l * D_ * DIN_; N_src = DIN_; K = D_; kend = D_; g = g0; b = b0; dst = p.Wb + WE_3 + (size_t)r * 32 * D_; gWo = p.aux + AUX_G3 + r * 32; bWo = p.aux + AUX_B3 + r * 32; }
        else if ((r -= 112) < 96) { src = SC_G + 32 * r; W = p.w_in + (size_t)l * D_ * DIN_; N_src = DIN_; K = D_; kend = D_; g = g0; b = b0; dst = p.Wb + WE_4 + (size_t)r * 32 * D_; gWo = p.aux + AUX_G4 + r * 32; bWo = p.aux + AUX_B4 + r * 32; }
        else if ((r -= 96) < 96) { const int br = r >> 5; W = inp[4 + br] + (size_t)l * 512 * D_; N_src = D_; K = 1536; kend = 512; src = 32 * (r & 31); dst = p.Wb + WE_5 + (size_t)(32 * (r & 31)) * 1536 + br * 512; }
        else if ((r -= 96) < 32) { W = p.w_out + (size_t)l * D_ * D_; N_src = D_; K = D_; kend = D_; src = 32 * r; dst = p.Wb + WE_6 + (size_t)r * 32 * D_; }
        else if ((r -= 32) < 176) { const int j = r >> 3, gi = r & 7; src = (gi < 4) ? 128 * j + 32 * gi : FF_ + 128 * j + 32 * (gi - 4);
            W = p.f2i + (size_t)l * D_ * 2 * FF_; N_src = 2 * FF_; K = D_; kend = D_; g = g1; b = b1; dst = p.Wb + WE_7 + (size_t)r * 32 * D_; gWo = p.aux + AUX_G7 + r * 32; bWo = p.aux + AUX_B7 + r * 32; }
        else { r -= 176; const int rg = r >> 2, kq = r & 3; W = p.f2o + (size_t)l * FF_ * D_; N_src = D_; K = FF_; kbeg = 704 * kq; kend = kbeg + 704; src = 32 * rg; dst = p.Wb + WE_8 + (size_t)rg * 32 * FF_; }
        prep_item(W, N_src, K, kbeg, kend, src, nv, g, b, dst, gWo, bWo, scr, lane);
    }
}
__device__ const double ROPE_INV[32] = {1.0, 0.7498942093324559, 0.5623413251903491, 0.4216965034285822, 0.31622776601683794, 0.23713737056616552, 0.1778279410038923, 0.1333521432163324, 0.1, 0.07498942093324558, 0.05623413251903491, 0.042169650342858224, 0.03162277660168379, 0.023713737056616554, 0.01778279410038923, 0.01333521432163324, 0.01, 0.007498942093324558, 0.005623413251903491, 0.004216965034285823, 0.0031622776601683794, 0.0023713737056616554, 0.0017782794100389228, 0.001333521432163324, 0.001, 0.0007498942093324559, 0.0005623413251903491, 0.00042169650342858224, 0.00031622776601683794, 0.00023713737056616554, 0.00017782794100389227, 0.0001333521432163324};
__device__ __forceinline__ double rope_inv(int i) { return ROPE_INV[i]; }
__device__ __forceinline__ void prologue(const Ptrs& p, int gtid, int ngt) {
    for (size_t c = gtid; c < (size_t)T_ * D_ / 8; c += ngt) { const f32x4 a = *(const f32x4*)(p.x + c * 8), b = *(const f32x4*)(p.x + c * 8 + 4);
        *(u32x4*)(p.Yb + c * 8) = pack8(a, b); }
    for (size_t c = gtid; c < (size_t)T_ * 8; c += ngt) { f32x4 v = (f32x4){0.f, 0.f, 0.f, 0.f}; if ((c & 7) == 0) v[1] = 1024.0f * (1.0f - LN_EPS_); *(f32x4*)(p.stats + (size_t)T_ * 32 + c * 4) = v; }
    for (size_t c = gtid; c < (size_t)T_ * 32; c += ngt) { const int t = (int)(c >> 5), i = (int)(c & 31); const double ang = (double)p.pos[t] * rope_inv(i);
        const double rev = ang * 0.15915494309189535; const double fr = rev - rint(rev); const float r = (float)(fr * 6.283185307179586);
        p.cosT[c] = __cosf(r); p.sinT[c] = __sinf(r); }
    for (int c = gtid; c < D_; c += ngt) { p.ones[c] = 1.f; p.zeros[c] = 0.f; }
}
__device__ __forceinline__ void combine_a(const Ptrs& p, int gtid, int ngt) {
    for (size_t c = gtid; c < (size_t)T_ * 64; c += ngt) { const size_t t = c >> 6; const int j = (int)(c & 63), h = j >> 3;
        const float L0 = p.LSE[t * 8 + h], L1 = p.LSE[(size_t)T_ * 8 + t * 8 + h], L2 = p.LSE[(size_t)2 * T_ * 8 + t * 8 + h];
        const float mx = fmaxf(L0, fmaxf(L1, L2)); float w0 = fast_exp2(L0 - mx), w1 = fast_exp2(L1 - mx), w2 = fast_exp2(L2 - mx); const float inv = fast_rcp(w0 + w1 + w2); w0 *= inv; w1 *= inv; w2 *= inv;
        bf16_t* o0 = p.OB + t * NO_ + j * 8; const bf16_t* o1 = p.ACX + t * 512 + j * 8; const bf16_t* o2 = p.ACX + (size_t)T_ * 512 + t * 512 + j * 8;
        f32x4 a0, b0, a1, b1, a2, b2; unpack8(*(const u32x4*)o0, a0, b0); unpack8(*(const u32x4*)o1, a1, b1); unpack8(*(const u32x4*)o2, a2, b2);
        *(u32x4*)o0 = pack8(a0 * w0 + a1 * w1 + a2 * w2, b0 * w0 + b1 * w1 + b2 * w2); }
}
__device__ __forceinline__ void final_ln(const Ptrs& p, const float* st, const float* g, const float* b, int gw, int ngw, int lane) {
    for (int row = gw; row < T_; row += ngw) { float mu, rs; row_stats(st, row, lane >> 4, mu, rs);
#pragma unroll
        for (int j = 0; j < 4; ++j) { float* yp = p.Y + (size_t)row * D_ + 256 * j + 4 * lane; const f32x4 v = *(const f32x4*)yp, gg = *(const f32x4*)(g + 256 * j + 4 * lane), bb = *(const f32x4*)(b + 256 * j + 4 * lane);
            *(f32x4*)yp = ((v - mu) * rs) * gg + bb; } }
}


typedef unsigned short bf16;
#define XB_TMO      128
#define XB_XCNT(j)  (256  + 64 * (j))
#define XB_XSUB(j)  (1280 + 64 * (j))
#define XB_XGEN(j)  (2304 + 64 * (j))
#define XB_TOP      3328
#define XB_TOPGEN   3392
#define XCD_BAR_WORDS 3456
#define XB_SPIN_CAP (1u << 18)

__device__ __forceinline__ unsigned xb_ld(unsigned* p)              { return __hip_atomic_load(p, __ATOMIC_RELAXED, __HIP_MEMORY_SCOPE_AGENT); }
__device__ __forceinline__ unsigned xb_add(unsigned* p, unsigned v) { return __hip_atomic_fetch_add(p, v, __ATOMIC_RELAXED, __HIP_MEMORY_SCOPE_AGENT); }
__device__ __forceinline__ unsigned xb_xcc_id() { return (unsigned)__builtin_amdgcn_s_getreg((3 << 11) | 20) & 0xFu; }
#define XB_SPIN(cond, bar) do { unsigned _sp = 0; while (cond) { __builtin_amdgcn_s_sleep(1); \
    if ((++_sp & 255u) == 0u) { if (xb_ld(&(bar)[XB_TMO])) break; if (_sp > XB_SPIN_CAP) { atomicAdd(&(bar)[XB_TMO], 1u); break; } } } } while (0)

struct XcdBarrier {
    unsigned* bar; unsigned x;
    volatile LAS unsigned* st;
};

__device__ __forceinline__ XcdBarrier xcd_barrier_post(unsigned* bar, volatile LAS unsigned* st) {
    XcdBarrier b; b.bar = bar; b.x = xb_xcc_id(); b.st = st;
    if (threadIdx.x == 0) (void)xb_add(&bar[XB_XCNT(b.x)], 1u);
    return b;
}
__device__ __forceinline__ void xcd_barrier_complete(unsigned* bar, unsigned x, unsigned& nloc, unsigned& nx) {
    const unsigned G = gridDim.x * gridDim.y * gridDim.z;
    unsigned sum, cnt, mine, sp = 0u;
    for (;;) {
        sum = 0u; cnt = 0u; mine = 0u;
#pragma unroll
        for (unsigned j = 0; j < 16; ++j) { const unsigned c = xb_ld(&bar[XB_XCNT(j)]); sum += c; cnt += (c > 0u) ? 1u : 0u; mine = (j == x) ? c : mine; }
        if (sum == G) break;
        __builtin_amdgcn_s_sleep(1);
        if ((++sp & 255u) == 0u) { if (xb_ld(&bar[XB_TMO])) break; if (sp > XB_SPIN_CAP) { atomicAdd(&bar[XB_TMO], 1u); break; } }
    }
    nloc = mine > 0u ? mine : 1u; nx = cnt > 0u ? cnt : 1u;
}

__device__ __forceinline__ void xcd_barrier(const XcdBarrier& b) {
    asm volatile("s_waitcnt vmcnt(0)" ::: "memory");
    __syncthreads();
    if (threadIdx.x == 0) {
        unsigned* bar = b.bar;
        __builtin_amdgcn_s_waitcnt(0);
        unsigned nloc = b.st[0], nx = b.st[1];
        if (nloc == 0u) { xcd_barrier_complete(bar, b.x, nloc, nx); b.st[0] = nloc; b.st[1] = nx; }
        const unsigned old = xb_add(&bar[XB_XSUB(b.x)], 1u);
        const unsigned gen = old / nloc;
        if (old + 1u == (gen + 1u) * nloc) {
            __builtin_amdgcn_fence(__ATOMIC_RELEASE, "agent");
            asm volatile("s_waitcnt vmcnt(0)" ::: "memory");
            const unsigned og = xb_add(&bar[XB_TOP], 1u);
            const unsigned tg = og / nx;
            if (og + 1u == (tg + 1u) * nx) xb_add(&bar[XB_TOPGEN], 1u);
            else XB_SPIN(xb_ld(&bar[XB_TOPGEN]) == tg, bar);
            __builtin_amdgcn_fence(__ATOMIC_ACQUIRE, "agent");
            xb_add(&bar[XB_XGEN(b.x)], 1u);
            asm volatile("s_waitcnt vmcnt(0)" ::: "memory");
        } else {
            XB_SPIN(xb_ld(&bar[XB_XGEN(b.x)]) == gen, bar);
            __builtin_amdgcn_fence(__ATOMIC_ACQUIRE, "agent");
            asm volatile("s_waitcnt vmcnt(0)" ::: "memory");
        }
    }
    __syncthreads();
}

constexpr int NWAVES = 8, LDS_BYTES = 131072 + 256, LDS_MISC = 131072;
constexpr size_t WS_CTL = 16 * MiB + 512 * 1024, CTL_BYTES = 16384;
#ifndef DSA_REPS
#define DSA_REPS 1
#endif
#ifndef BAND_REPS
#define BAND_REPS 1
#endif
#ifndef BAND_NQ
#define BAND_NQ 2
#endif
#ifndef G6_REPS
#define G6_REPS 1
#endif
#ifndef ATT_REPS
#define ATT_REPS 1
#endif
#ifndef PREP_REPS
#define PREP_REPS 1
#endif
constexpr int NPHASE = 10 * DEPTH_ + 1;
static_assert(C_LDS_END <= LDS_BYTES && 8 * 8448 <= LDS_BYTES, "LDS map");
struct Args { const float* in[14]; float* out; unsigned char* ws; int lo, hi; };
__global__ void __launch_bounds__(NWAVES * 64, 2) mega(Args a) {
    extern __shared__ __attribute__((aligned(16))) unsigned char lds_raw[];
    LAS unsigned char* lds = (LAS unsigned char*)lds_raw;
    const int wave = __builtin_amdgcn_readfirstlane((int)threadIdx.x >> 6);
#define OTID() ({ int t_ = threadIdx.x; asm volatile("" : "+v"(t_)); t_; })
#define LANE() (OTID() & 63)
#define GTID() (vcu * NWAVES * 64 + OTID())
    const int G = gridDim.x, bx = blockIdx.x, vcu = (G % 8 == 0) ? (bx % 8) * (G / 8) + bx / 8 : bx;
    const int gw = vcu * NWAVES + wave, ngw = G * NWAVES, ngt = G * NWAVES * 64;
    Ptrs p;
    p.x = a.in[0]; p.pos = (const int*)a.in[1]; p.w_in = a.in[2]; p.sink = a.in[3];  p.w_out = a.in[7];
    p.f1i = a.in[8]; p.f1o = a.in[9]; p.f2i = a.in[10]; p.f2o = a.in[11]; p.lng = a.in[12]; p.lnb = a.in[13];
    unsigned char* ws = a.ws;
    p.Y = a.out; p.stats = (float*)(ws + WS_STATS); p.cosT = (float*)(ws + WS_ROPE); p.sinT = p.cosT + (size_t)T_ * 32; p.ones = (float*)(ws + WS_LNV); p.zeros = p.ones + 1024;
    p.aux = (float*)(ws + WS_AUX); p.LSE = (float*)(ws + WS_LSE); p.Yb = (bf16_t*)(ws + WS_YB); p.Wb = (bf16_t*)(ws + WS_W); p.BIG = (bf16_t*)(ws + WS_BIG); p.OB = (bf16_t*)(ws + WS_OBUF); p.ACX = (bf16_t*)(ws + WS_ACX);
#if !MK_MULTI
    cg::grid_group grid = cg::this_grid();
    if (threadIdx.x < 64) ((LAS unsigned*)(lds + LDS_MISC))[threadIdx.x] = 0u;
    __syncthreads();
    XcdBarrier xbar = xcd_barrier_post((unsigned*)(a.ws + WS_CTL), (volatile LAS unsigned*)(lds + LDS_MISC));
#endif
    const int lo = a.lo, hi = a.hi;
#define IN(k) (lo <= (k) && (k) < hi)
#if MK_MULTI
#define SEAM(k) do { } while (0)
#else
#define SEAM(k) do { if (IN(k) && IN((k) + 1)) { if ((k) == 0) grid.sync(); else xcd_barrier(xbar); } } while (0)
#endif
    for (int l = 0; l < DEPTH_; ++l) {
        const int pb = 10 * l;
        const int s0 = 3 * l;
        const float* gp; const float* bp;
        if (IN(pb + 0)) for (int rep_ = 0; rep_ < PREP_REPS; ++rep_) {
#ifndef NO_PREP
 prep_layer(p, a.in, l, lds, gw, ngw, wave, LANE()); if (l == 0) prologue(p, GTID(), ngt);
#endif
 }
        SEAM(pb + 0);
        if (IN(pb + 1)) {
#ifndef NO_G1
 pg8::Gemm g{p.Yb, p.Wb + WE_1, D_, D_}; pg8::StaticOrder S; S.init(T_, 2 * FF_, G, bx);
            EpiSwiglu E{p.BIG, p.stats + (size_t)((s0 + 1) & 1) * T_ * 32, p.aux + AUX_G1, p.aux + AUX_B1};
            pg8::gemm_phase<EpiSwiglu, pg8::StaticOrder, true, true>(lds, g, S, E);
#endif
        }
        SEAM(pb + 1);
        if (IN(pb + 2)) {
#ifndef NO_G2
 pg8::Gemm g{p.BIG, p.Wb + WE_2, FF_, FF_}; pg8::StaticOrder S; S.init(T_, D_, G, bx);
            gp = (l == 0) ? p.ones : p.lng + (size_t)((l - 1) * 3 + 2) * D_; bp = (l == 0) ? p.zeros : p.lnb + (size_t)((l - 1) * 3 + 2) * D_;
            EpiResid E{(l == 0) ? p.x : p.Y, p.Y, p.Yb, p.stats + (size_t)((s0 + 1) & 1) * T_ * 32, p.stats + (size_t)(s0 & 1) * T_ * 32, gp, bp, 0.5f};
            pg8::gemm_phase<EpiResid, pg8::StaticOrder, true, true>(lds, g, S, E);
#endif
        }
        SEAM(pb + 2);
        if (IN(pb + 3)) {
#ifndef NO_G3
 pg8::Gemm g{p.Yb, p.Wb + WE_3, D_, D_}; pg8::StaticOrder S; S.init(T_, NP_, G, bx);
            EpiProj E{p.BIG, p.stats + (size_t)(s0 & 1) * T_ * 32, p.aux + AUX_G3, p.aux + AUX_B3, p.cosT, p.sinT};
            pg8::gemm_phase<EpiProj, pg8::StaticOrder, true, true>(lds, g, S, E);
#endif
        }
        SEAM(pb + 3);
        if (IN(pb + 4)) for (int rep_ = 0; rep_ < ATT_REPS; ++rep_) {
#ifndef NO_DSA
            for (int dr_ = 0; dr_ < DSA_REPS; ++dr_) for (int idx = vcu; idx < NB_ * 128; idx += G) { const int k = idx >> 8, v = idx & 255, b = (v >> 5) + 8 * (k & 1), c32 = v & 31, k2 = k >> 1, blk = 32 * k2 + ((k2 & 1) ? 31 - c32 : c32);
                dsa_unit(b, blk, p.BIG, p.OB, lds, wave, OTID()); }
#endif
#ifndef NO_BAND
            LAS unsigned char* vl = lds + C_VST + wave * 4096;
            for (int br_ = 0; br_ < BAND_REPS; ++br_) for (int u = gw; u < 4 * NB_ * 8 * (SEQ_ / (16 * BAND_NQ)); u += ngw) band_unit<BAND_NQ>(u, p.BIG, p.OB, p.ACX, p.LSE, p.sink + l * 8, vl, LANE());
#endif
        }
        SEAM(pb + 4);
        if (IN(pb + 5)) {
#ifndef NO_G5
 combine_a(p, GTID(), ngt);
            pg8::Gemm g{p.Yb, p.Wb + WE_4, D_, D_}; pg8::StaticOrder S; S.init(T_, NG_, G, bx);
            EpiGate E{p.BIG, p.stats + (size_t)(s0 & 1) * T_ * 32, p.aux + AUX_G4, p.aux + AUX_B4};
            pg8::gemm_phase<EpiGate, pg8::StaticOrder, true, true>(lds, g, S, E);
#endif
        }
        SEAM(pb + 5);
        if (IN(pb + 6)) for (int rep_ = 0; rep_ < G6_REPS; ++rep_) {
#ifndef NO_G6
 pg8::Gemm g{p.OB, p.Wb + WE_5, NO_, NO_}; pg8::StaticOrder S; S.init(T_, D_, G, bx);
            EpiBranch E{p.BIG, p.ACX};
            pg8::gemm_phase<EpiBranch, pg8::StaticOrder, true, true>(lds, g, S, E);
#endif
        }
        SEAM(pb + 6);
        if (IN(pb + 7)) {
#ifndef NO_G7
 pg8::Gemm g{p.ACX, p.Wb + WE_6, D_, D_}; pg8::StaticOrder S; S.init(T_, D_, G, bx);
            EpiResid E{p.Y, p.Y, p.Yb, p.stats + (size_t)(s0 & 1) * T_ * 32, p.stats + (size_t)((s0 + 1) & 1) * T_ * 32, p.lng + (size_t)(l * 3 + 0) * D_, p.lnb + (size_t)(l * 3 + 0) * D_, 1.0f};
            pg8::gemm_phase<EpiResid, pg8::StaticOrder, true, true>(lds, g, S, E);
#endif
        }
        SEAM(pb + 7);
        if (IN(pb + 8)) {
#ifndef NO_G8
 pg8::Gemm g{p.Yb, p.Wb + WE_7, D_, D_}; pg8::StaticOrder S; S.init(T_, 2 * FF_, G, bx);
            EpiSwiglu E{p.BIG, p.stats + (size_t)((s0 + 1) & 1) * T_ * 32, p.aux + AUX_G7, p.aux + AUX_B7};
            pg8::gemm_phase<EpiSwiglu, pg8::StaticOrder, true, true>(lds, g, S, E);
#endif
        }
        SEAM(pb + 8);
        if (IN(pb + 9)) {
#ifndef NO_G9
 pg8::Gemm g{p.BIG, p.Wb + WE_8, FF_, FF_}; pg8::StaticOrder S; S.init(T_, D_, G, bx);
            EpiResid E{p.Y, p.Y, p.Yb, p.stats + (size_t)((s0 + 1) & 1) * T_ * 32, p.stats + (size_t)(s0 & 1) * T_ * 32, p.lng + (size_t)(l * 3 + 1) * D_, p.lnb + (size_t)(l * 3 + 1) * D_, 0.5f};
            pg8::gemm_phase<EpiResid, pg8::StaticOrder, true, true>(lds, g, S, E);
#endif
        }
        SEAM(pb + 9);
    }
    if (IN(10 * DEPTH_)) final_ln(p, p.stats + (size_t)T_ * 32, p.lng + (size_t)((DEPTH_ - 1) * 3 + 2) * D_, p.lnb + (size_t)((DEPTH_ - 1) * 3 + 2) * D_, gw, ngw, LANE());
#undef IN
#undef SEAM
}

extern "C" void kernel_launch(void* const* d_in, const int* in_sizes, int n_in, void* d_out, int out_size, void* d_ws, size_t ws_size, hipStream_t stream) {
    static int grid = 0;
    if (grid == 0) {
        if (n_in != 14 || in_sizes[0] != T_ * D_ || out_size != T_ * D_ || ws_size < WS_END) { fprintf(stderr, "kernel_launch: unexpected shapes/workspace (n_in %d, ws %zu, need %zu)\n", n_in, ws_size, (size_t)WS_END); grid = -1; return; }
        int dev = 0, cus = 0, per_cu = 0;
        if (hipGetDevice(&dev) != hipSuccess || hipDeviceGetAttribute(&cus, hipDeviceAttributeMultiprocessorCount, dev) != hipSuccess) { grid = -1; return; }
        if (hipFuncSetAttribute((const void*)mega, hipFuncAttributeMaxDynamicSharedMemorySize, LDS_BYTES) != hipSuccess) { fprintf(stderr, "kernel_launch: hipFuncSetAttribute failed\n"); grid = -1; return; }
        if (hipOccupancyMaxActiveBlocksPerMultiprocessor(&per_cu, (const void*)mega, NWAVES * 64, LDS_BYTES) != hipSuccess || per_cu < 1) { fprintf(stderr, "kernel_launch: occupancy query says %d\n", per_cu); per_cu = 1; }
        (void)hipGetLastError();
        grid = cus * 1;
    }
    if (grid < 0) return;
    Args a{};
    for (int i = 0; i < 14; ++i) a.in[i] = (const float*)d_in[i];
    a.out = (float*)d_out; a.ws = (unsigned char*)d_ws;
#if MK_MULTI
    for (int ph = 0; ph < NPHASE; ++ph) { a.lo = ph; a.hi = ph + 1; hipLaunchKernelGGL(mega, dim3(grid), dim3(NWAVES * 64), LDS_BYTES, stream, a); }
#else
    a.lo = 0; a.hi = NPHASE;
    if (hipMemsetAsync((char*)d_ws + WS_CTL, 0, CTL_BYTES, stream) != hipSuccess) { fprintf(stderr, "kernel_launch: memset failed\n"); return; }
    void* args[] = {&a};
    hipError_t e = hipLaunchCooperativeKernel((const void*)mega, dim3(grid), dim3(NWAVES * 64), args, LDS_BYTES, stream);
    if (e != hipSuccess) fprintf(stderr, "kernel_launch: cooperative launch failed: %s (grid %d)\n", hipGetErrorString(e), grid);
#endif
}
```

```cpp
#define BAND_NQ 4
#include <hip/hip_runtime.h>
#include <hip/hip_cooperative_groups.h>
#include <cstdio>
#include <cstdint>
namespace cg = cooperative_groups;

#ifndef MK_MULTI
#define MK_MULTI 0
#endif

constexpr int T_ = 32768, D_ = 1024, FF_ = 2816, SEQ_ = 2048, NB_ = 16, DEPTH_ = 4;
constexpr int NP_ = 3584, NG_ = 3072, NO_ = 1536, DIN_ = 6600;
constexpr float LN_EPS_ = 1e-5f;
constexpr float ALPHA_ = 1.6817928305074292f;
constexpr float SC2_ = 0.125f * 1.4426950408889634f;
constexpr int PC_QA = 0, PC_KA = 512, PC_QB = 1024, PC_QC = 1536, PC_QI = 2048, PC_KB = 2560, PC_KC = 2688, PC_KI = 2752, PC_VA = 2816, PC_VB = 3328, PC_VC = 3456, PC_WI = 3520;
constexpr int SC_QA = 0, SC_KA = 512, SC_VA = 1024, SC_QB = 1536, SC_KB = 2048, SC_VB = 2176, SC_QC = 2304, SC_KC = 2816, SC_VC = 2880, SC_QI = 2944, SC_KI = 3456, SC_WI = 3520, SC_G = 3528;

constexpr size_t MiB = 1u << 20;
constexpr size_t WS_STATS = 0;
constexpr size_t WS_ROPE  = 8 * MiB;
constexpr size_t WS_LNV   = 16 * MiB;
constexpr size_t WS_AUX   = WS_LNV + 8192;
constexpr int AUX_G1 = 0, AUX_B1 = 5632, AUX_G3 = 11264, AUX_B3 = 14848, AUX_G4 = 18432, AUX_B4 = 21504, AUX_G7 = 24576, AUX_B7 = 30208, AUX_END = 35840;
constexpr size_t WS_LSE   = 17 * MiB;
constexpr size_t WS_YB    = 20 * MiB;
constexpr size_t WS_W     = 84 * MiB;
constexpr size_t WE_1 = 0, WE_2 = WE_1 + (size_t)5632 * 1024, WE_3 = WE_2 + (size_t)1024 * 2816, WE_4 = WE_3 + (size_t)3584 * 1024, WE_5 = WE_4 + (size_t)3072 * 1024,
                 WE_6 = WE_5 + (size_t)3072 * 512, WE_7 = WE_6 + (size_t)1024 * 1024, WE_8 = WE_7 + (size_t)5632 * 1024, WE_END = WE_8 + (size_t)1024 * 2816;
static_assert(WE_END * 2 <= 52 * MiB, "weights");
constexpr size_t WS_BIG   = 136 * MiB;
constexpr size_t WS_OBUF  = 360 * MiB;
constexpr size_t WS_ACX   = 456 * MiB;
constexpr size_t WS_END   = 520 * MiB;
static_assert(WS_AUX + AUX_END * 4 <= WS_LSE && WS_LSE + 3 * MiB <= WS_YB && WS_BIG + (size_t)T_ * NP_ * 2 <= WS_OBUF, "ws map");

#define LAS __attribute__((address_space(3)))
typedef unsigned short bf16_t;
typedef short bf16x8 __attribute__((ext_vector_type(8)));
typedef short s16x4 __attribute__((ext_vector_type(4)));
typedef float f32x4 __attribute__((ext_vector_type(4)));
typedef float f32x2 __attribute__((ext_vector_type(2)));
typedef unsigned u32x4 __attribute__((ext_vector_type(4)));
typedef unsigned u32x2 __attribute__((ext_vector_type(2)));
__device__ __forceinline__ unsigned f2bf(float f) { unsigned u = __float_as_uint(f); return (u + 0x7fffu + ((u >> 16) & 1u)) >> 16; }
__device__ __forceinline__ float bf2f(unsigned v) { return __uint_as_float(v << 16); }
typedef __bf16 bf16x2_t __attribute__((ext_vector_type(2)));
__device__ __forceinline__ unsigned cvt_pk_bf16(float lo, float hi) { const f32x2 v = {lo, hi}; const bf16x2_t b = __builtin_convertvector(v, bf16x2_t); return __builtin_bit_cast(unsigned, b); }
__device__ __forceinline__ float fast_exp2(float x) { return __builtin_amdgcn_exp2f(x); }
__device__ __forceinline__ float fast_rcp(float x) { return __builtin_amdgcn_rcpf(x); }
__device__ __forceinline__ float xmax16(float v) { const auto r = __builtin_amdgcn_permlane16_swap(__float_as_uint(v), __float_as_uint(v), false, false); return fmaxf(__uint_as_float(r[0]), __uint_as_float(r[1])); }
__device__ __forceinline__ float xmax32(float v) { const auto r = __builtin_amdgcn_permlane32_swap(__float_as_uint(v), __float_as_uint(v), false, false); return fmaxf(__uint_as_float(r[0]), __uint_as_float(r[1])); }
__device__ __forceinline__ float xsum16(float v) { const auto r = __builtin_amdgcn_permlane16_swap(__float_as_uint(v), __float_as_uint(v), false, false); return __uint_as_float(r[0]) + __uint_as_float(r[1]); }
__device__ __forceinline__ float xsum32(float v) { const auto r = __builtin_amdgcn_permlane32_swap(__float_as_uint(v), __float_as_uint(v), false, false); return __uint_as_float(r[0]) + __uint_as_float(r[1]); }
__device__ __forceinline__ float sigmoid_f(float x) { return fast_rcp(1.0f + fast_exp2(-1.4426950408889634f * x)); }
__device__ __forceinline__ void row_stats(const float* st, int row, int fq, float& mu, float& rstd) {
    const f32x4* p = (const f32x4*)(st + (size_t)row * 32 + fq * 8);
    const f32x4 a = p[0], b = p[1];
    float s1 = (a[0] + a[2]) + (b[0] + b[2]), s2 = (a[1] + a[3]) + (b[1] + b[3]);
    s1 = xsum32(xsum16(s1)); s2 = xsum32(xsum16(s2));
    mu = s1 * (1.0f / 1024.0f); const float var = fmaxf(s2 * (1.0f / 1024.0f) - mu * mu, 0.f); rstd = rsqrtf(var + LN_EPS_);
}

__device__ __forceinline__ size_t blk_off(int r, int c, int K) { return (size_t)(r >> 8) * 256 * K + (size_t)(c >> 6) * (256 * 64) + (size_t)((r & 255) * 64 + (c & 63)); }

namespace pg8 {
#define PG8_LAS __attribute__((address_space(3)))
constexpr int BM = 256, BK = 64, HALF = 128, HTB = HALF * BK * 2, STAGE_BYTES = 8 * HTB, NXCD = 8, WGM = 8;
__host__ __device__ __forceinline__ int lds_byte(int r, int c) { const int st = (r >> 4) * 2 + (c >> 5), rr = r & 15, cc = c & 31, ob = rr * 64 + cc * 2; return st * 1024 + (ob ^ (((ob >> 9) & 1) << 5)); }
__host__ __device__ __forceinline__ void stage_rc(int b, int& R, int& C) { const int st = b / 1024, sb = b % 1024, swz = sb ^ (((sb >> 9) & 1) << 5); R = (st >> 1) * 16 + swz / 64; C = (st & 1) * 32 + (swz % 64) / 2; }
__host__ __device__ __forceinline__ int perm32(int rho) { const int n = rho >> 4, i = rho & 15; return 8 * (i >> 2) + 4 * n + (i & 3); }
struct Unit { int pm, pn, ac; };
struct Gemm { const bf16_t* A; const bf16_t* Bt; int lda, K, blk; };
struct StaticOrder {
    int nM, nN, nwg, G, c;
    __device__ void init(int M, int N, int G_, int c_) { nM = M / BM; nN = N / BM; nwg = nM * nN; G = G_; c = c_; }
    __device__ bool next(int i, Unit& u) const {
        const long L = (long)i * G + c; if (L >= nwg) return false;
        int wgid = (int)L; { const int q = nwg / NXCD, r = nwg % NXCD, xcd = wgid % NXCD, off = wgid / NXCD; wgid = (xcd < r ? xcd * (q + 1) : r * (q + 1) + (xcd - r) * q) + off; }
        const int nig = WGM * nN, gid = wgid / nig, fm = gid * WGM, gsz = (nM - fm) < WGM ? (nM - fm) : WGM;
        u.pm = fm + ((wgid % nig) % gsz); u.pn = (wgid % nig) / gsz; u.ac = 0; return true;
    }
    __device__ __forceinline__ void a_ready(const Unit&) const {}
    __device__ __forceinline__ void done(const Unit&) const {}
};
struct BranchOrder {
    StaticOrder so;
    __device__ void init(int G_, int c_) { so.init(T_, 1024, G_, c_); }
    __device__ bool next(int i, Unit& u) const { const int br = i % 3; if (!so.next(i / 3, u)) return false; u.pn += 4 * br; u.ac = br * 512 * 2; return true; }
    __device__ __forceinline__ void a_ready(const Unit&) const {}
    __device__ __forceinline__ void done(const Unit&) const {}
};
template <class Epi, class Sched, bool ALIGN_EPI = false, bool SP2 = false>
__device__ __forceinline__ void gemm_phase(PG8_LAS unsigned char* lds, const Gemm g, const Sched& S, const Epi& E) {
    int tid_ = threadIdx.x; asm volatile("" : "+v"(tid_));
    const int tid = tid_, wid = __builtin_amdgcn_readfirstlane(tid >> 6), lane = tid & 63, wr = wid >> 2, wc = wid & 3, fr = lane & 15, fq = lane >> 4;
    const int K = g.K, nt = K / BK, LDA = g.lda;
    unsigned voffA[2], voffB[2];
#pragma unroll
    for (int i = 0; i < 2; ++i) { int R, C; stage_rc(tid * 16 + i * 8192, R, C); const int Rb = Epi::PERM ? ((R & ~31) + perm32(R & 31)) : R;
        voffA[i] = (unsigned)(R * LDA + C) * 2u; voffB[i] = (unsigned)(Rb * K + C) * 2u; }
    const size_t kstepB = (size_t)(BK * 2), kstepA = g.blk ? (size_t)(BM * BK * 2) : kstepB;
    const size_t hstepB = (size_t)HALF * K * 2, hstepA = (size_t)HALF * LDA * 2;
    const size_t tstepA = g.blk ? (size_t)BM * K * 2 : 2 * hstepA, tstepB = 2 * hstepB;
    const unsigned ldsw = (unsigned)wid * 1024u;
    const int aoff = lds_byte(wr * 64 + fr, fq * 8), boff = lds_byte(wc * 32 + fr, fq * 8);
#define PG8_SA(b, h) (((b) * 2 + (h)) * HTB)
#define PG8_SB(b, h) ((4 + (b) * 2 + (h)) * HTB)
#define PG8_STAGE(bufoff, gbase, voff) do { _Pragma("unroll") for (int _i = 0; _i < 2; ++_i) \
        __builtin_amdgcn_global_load_lds((const unsigned*)((const char*)(gbase) + (voff)[_i]), (PG8_LAS unsigned*)(lds + (bufoff) + ldsw + _i * 8192), 16, 0, 0); } while (0)
#define PG8_LDA(dst, b, h) do { _Pragma("unroll") for (int m = 0; m < 4; ++m) _Pragma("unroll") for (int k = 0; k < 2; ++k) dst[m][k] = *(const PG8_LAS bf16x8*)(lds + PG8_SA(b, h) + aoff + m * 2048 + k * 1024); } while (0)
#define PG8_LDB(dst, b, h) do { _Pragma("unroll") for (int n = 0; n < 2; ++n) _Pragma("unroll") for (int k = 0; k < 2; ++k) dst[n][k] = *(const PG8_LAS bf16x8*)(lds + PG8_SB(b, h) + boff + n * 2048 + k * 1024); } while (0)
#define PG8_MMA(ai, bj, At, Bt) do { __builtin_amdgcn_s_setprio(1); _Pragma("unroll") for (int m = 0; m < 4; ++m) _Pragma("unroll") for (int n = 0; n < 2; ++n) _Pragma("unroll") for (int k = 0; k < 2; ++k) \
        acc[ai][bj][m][n] = __builtin_amdgcn_mfma_f32_16x16x32_bf16(Bt[n][k], At[m][k], acc[ai][bj][m][n], 0, 0, 0); __builtin_amdgcn_s_setprio(0); } while (0)
#define PG8_WAIT_V(n) asm volatile("s_waitcnt vmcnt(" #n ")" ::: "memory")
#define PG8_WAIT_L(n) asm volatile("s_waitcnt lgkmcnt(" #n ")" ::: "memory")
#define PG8_BAR __builtin_amdgcn_s_barrier()
#define PG8_SCHED __builtin_amdgcn_sched_barrier(0)
    Unit cur, nxt; int ui = 0;
    if (!S.next(0, cur)) return;
    f32x4 acc[2][2][4][2];
#pragma unroll
    for (int a = 0; a < 2; ++a)
#pragma unroll
        for (int b = 0; b < 2; ++b)
#pragma unroll
            for (int m = 0; m < 4; ++m)
#pragma unroll
                for (int n = 0; n < 2; ++n) acc[a][b][m][n] = (f32x4){0.f, 0.f, 0.f, 0.f};
    bf16x8 At[4][2], B0[2][2], B1[2][2];
    const char* cA = (const char*)g.A + (size_t)cur.pm * tstepA + cur.ac; const char* cB = (const char*)g.Bt + (size_t)cur.pn * tstepB;
    S.a_ready(cur);
    if constexpr (SP2) {
        PG8_STAGE(PG8_SB(0, 0), cB, voffB); PG8_STAGE(PG8_SB(0, 1), cB + hstepB, voffB); PG8_STAGE(PG8_SA(0, 0), cA, voffA); PG8_STAGE(PG8_SA(0, 1), cA + hstepA, voffA);
        if (wr == 1) PG8_BAR;
        PG8_WAIT_V(2); PG8_BAR;
        PG8_STAGE(PG8_SB(1, 0), cB + kstepB, voffB); PG8_STAGE(PG8_SA(1, 0), cA + kstepA, voffA); PG8_STAGE(PG8_SB(1, 1), cB + hstepB + kstepB, voffB);
        PG8_WAIT_V(6); PG8_BAR;
    } else {
        PG8_STAGE(PG8_SB(0, 0), cB, voffB); PG8_STAGE(PG8_SA(0, 0), cA, voffA); PG8_STAGE(PG8_SB(0, 1), cB + hstepB, voffB); PG8_STAGE(PG8_SA(0, 1), cA + hstepA, voffA);
        if (wr == 1) PG8_BAR;
        PG8_WAIT_V(4); PG8_BAR;
        PG8_STAGE(PG8_SB(1, 0), cB + kstepB, voffB); PG8_STAGE(PG8_SA(1, 0), cA + kstepA, voffA); PG8_STAGE(PG8_SB(1, 1), cB + hstepB + kstepB, voffB);
        PG8_WAIT_V(6); PG8_BAR;
    }
    for (;;) {
        const bool has_next = S.next(ui + 1, nxt);
        const char* nA = has_next ? (const char*)g.A + (size_t)nxt.pm * tstepA + nxt.ac : cA; const char* nB = has_next ? (const char*)g.Bt + (size_t)nxt.pn * tstepB : cB;
        for (int t = 0; t < nt; t += 2) {
            if constexpr (Epi::MIDK) { if (t == 8 || t == 16) E.mid(acc, cur, t, wr, wc, fr, fq); }
            const bool last = (t == nt - 2);
            const char* a1 = cA + (size_t)(t + 1) * kstepA;
            const char* a2 = last ? nA : cA + (size_t)(t + 2) * kstepA; const char* b2 = last ? nB : cB + (size_t)(t + 2) * kstepB;
            const char* a3 = a2 + kstepA; const char* b3 = b2 + kstepB;
            if (last && has_next) S.a_ready(nxt);
            if constexpr (SP2) {
            PG8_LDB(B0, 0, 0); PG8_LDB(B1, 0, 1); PG8_SCHED; PG8_LDA(At, 0, 0); PG8_STAGE(PG8_SA(1, 1), a1 + hstepA, voffA);
            PG8_WAIT_V(8); PG8_WAIT_L(0); PG8_BAR; PG8_MMA(0, 0, At, B0); PG8_MMA(0, 1, At, B1); PG8_BAR; PG8_SCHED;
            PG8_LDA(At, 0, 1); PG8_STAGE(PG8_SB(0, 0), b2, voffB); PG8_STAGE(PG8_SB(0, 1), b2 + hstepB, voffB); PG8_STAGE(PG8_SA(0, 0), a2, voffA);
            PG8_WAIT_V(8); PG8_WAIT_L(0); PG8_BAR; PG8_MMA(1, 0, At, B0); PG8_MMA(1, 1, At, B1); PG8_BAR; PG8_SCHED;
            PG8_LDB(B0, 1, 0); PG8_LDB(B1, 1, 1); PG8_SCHED; PG8_LDA(At, 1, 0); PG8_STAGE(PG8_SA(0, 1), a2 + hstepA, voffA);
            PG8_WAIT_V(8); PG8_WAIT_L(0); PG8_BAR; PG8_MMA(0, 0, At, B0); PG8_MMA(0, 1, At, B1); PG8_BAR; PG8_SCHED;
            PG8_LDA(At, 1, 1); PG8_STAGE(PG8_SB(1, 0), b3, voffB); PG8_STAGE(PG8_SB(1, 1), b3 + hstepB, voffB); PG8_STAGE(PG8_SA(1, 0), a3, voffA);
            PG8_WAIT_V(8); PG8_WAIT_L(0); PG8_BAR; PG8_MMA(1, 0, At, B0); PG8_MMA(1, 1, At, B1); PG8_BAR; PG8_SCHED;
            } else {
            PG8_LDB(B0, 0, 0); PG8_SCHED; PG8_LDA(At, 0, 0); PG8_STAGE(PG8_SA(1, 1), a1 + hstepA, voffA);
            PG8_WAIT_L(8); PG8_BAR; PG8_WAIT_L(0); PG8_MMA(0, 0, At, B0); PG8_BAR; PG8_SCHED;
            PG8_LDB(B1, 0, 1); PG8_STAGE(PG8_SB(0, 0), b2, voffB);
            PG8_BAR; PG8_WAIT_L(0); PG8_MMA(0, 1, At, B1); PG8_BAR;
            PG8_LDA(At, 0, 1); PG8_STAGE(PG8_SA(0, 0), a2, voffA);
            PG8_BAR; PG8_WAIT_L(0); PG8_MMA(1, 0, At, B0); PG8_BAR; PG8_SCHED;
            PG8_STAGE(PG8_SB(0, 1), b2 + hstepB, voffB);
            PG8_WAIT_V(6); PG8_BAR; PG8_MMA(1, 1, At, B1); PG8_BAR;
            PG8_LDB(B0, 1, 0); PG8_SCHED; PG8_LDA(At, 1, 0); PG8_STAGE(PG8_SA(0, 1), a2 + hstepA, voffA);
            PG8_WAIT_L(8); PG8_BAR; PG8_WAIT_L(0); PG8_MMA(0, 0, At, B0); PG8_BAR; PG8_SCHED;
            PG8_LDB(B1, 1, 1); PG8_STAGE(PG8_SB(1, 0), b3, voffB);
            PG8_BAR; PG8_WAIT_L(0); PG8_MMA(0, 1, At, B1); PG8_BAR;
            PG8_LDA(At, 1, 1); PG8_STAGE(PG8_SA(1, 0), a3, voffA);
            PG8_BAR; PG8_WAIT_L(0); PG8_MMA(1, 0, At, B0); PG8_BAR; PG8_SCHED;
            PG8_STAGE(PG8_SB(1, 1), b3 + hstepB, voffB);
            PG8_WAIT_V(6); PG8_BAR; PG8_MMA(1, 1, At, B1); PG8_BAR;
            }
        }
        if constexpr (ALIGN_EPI) { if (wr == 0) PG8_BAR; }
        if constexpr (!Epi::AFTER_DRAIN) { E(acc, cur, wr, wc, fr, fq); S.done(cur); }
        if (!has_next) break;
#pragma unroll
        for (int a = 0; a < 2; ++a)
#pragma unroll
            for (int b = 0; b < 2; ++b)
#pragma unroll
                for (int m = 0; m < 4; ++m)
#pragma unroll
                    for (int n = 0; n < 2; ++n) acc[a][b][m][n] = (f32x4){0.f, 0.f, 0.f, 0.f};
        cur = nxt; cA = nA; cB = nB; ++ui;
        if constexpr (ALIGN_EPI) { if (wr == 1) PG8_BAR; }
    }
    PG8_WAIT_V(0);
    if constexpr (!ALIGN_EPI) { if (wr == 0) PG8_BAR; }
    PG8_BAR;
    if constexpr (Epi::AFTER_DRAIN) { E.fused(acc, cur, wr, wc, fr, fq, lds, wid, lane); S.done(cur); }
#undef PG8_SA
#undef PG8_SB
#undef PG8_STAGE
#undef PG8_LDA
#undef PG8_LDB
#undef PG8_MMA
#undef PG8_WAIT_V
#undef PG8_WAIT_L
#undef PG8_BAR
#undef PG8_SCHED
}
}

__device__ __forceinline__ u32x4 pack8(const f32x4 a, const f32x4 b) { u32x4 w; w.x = cvt_pk_bf16(a[0], a[1]); w.y = cvt_pk_bf16(a[2], a[3]); w.z = cvt_pk_bf16(b[0], b[1]); w.w = cvt_pk_bf16(b[2], b[3]); return w; }
__device__ __forceinline__ void unpack8(const u32x4 w, f32x4& a, f32x4& b) {
    a[0] = __uint_as_float(w.x << 16); a[1] = __uint_as_float(w.x & 0xffff0000u); a[2] = __uint_as_float(w.y << 16); a[3] = __uint_as_float(w.y & 0xffff0000u);
    b[0] = __uint_as_float(w.z << 16); b[1] = __uint_as_float(w.z & 0xffff0000u); b[2] = __uint_as_float(w.w << 16); b[3] = __uint_as_float(w.w & 0xffff0000u); }
__device__ __forceinline__ f32x4 silu_mul(const f32x4 g, const f32x4 u) { f32x4 r;
#pragma unroll
    for (int e = 0; e < 4; ++e) r[e] = g[e] * sigmoid_f(g[e]) * u[e];
    return r; }

__device__ __forceinline__ void row_stats4(const float* st, int rowb, int fq, float (&mu)[4], float (&rs)[4]) {
    f32x4 a[4], b[4];
#pragma unroll
    for (int m = 0; m < 4; ++m) { const f32x4* p = (const f32x4*)(st + (size_t)(rowb + m * 16) * 32 + fq * 8); a[m] = p[0]; b[m] = p[1]; }
#pragma unroll
    for (int m = 0; m < 4; ++m) { float s1 = (a[m][0] + a[m][2]) + (b[m][0] + b[m][2]), s2 = (a[m][1] + a[m][3]) + (b[m][1] + b[m][3]);
        s1 = xsum32(xsum16(s1)); s2 = xsum32(xsum16(s2));
        const float mm = s1 * (1.0f / 1024.0f); mu[m] = mm; rs[m] = rsqrtf(fmaxf(s2 * (1.0f / 1024.0f) - mm * mm, 0.f) + LN_EPS_); }
    asm volatile("" ::: "memory");
}
struct EpiSwiglu {
    static constexpr bool PERM = true, AFTER_DRAIN = false, MIDK = false;
    bf16_t* H; const float* st; const float* gW; const float* bW;
    __device__ __forceinline__ void operator()(const f32x4 (&acc)[2][2][4][2], const pg8::Unit& u, int wr, int wc, int fr, int fq) const {
        const int row0 = u.pm * 256 + wr * 64 + fr, cl = wc * 32 + fq * 8, cB0 = u.pn * 256 + cl;
        f32x4 g0[2], g1[2], b0[2], b1[2];
#pragma unroll
        for (int n = 0; n < 2; ++n) { g0[n] = *(const f32x4*)(gW + cB0 + 4 * n); g1[n] = *(const f32x4*)(gW + cB0 + 128 + 4 * n); b0[n] = *(const f32x4*)(bW + cB0 + 4 * n); b1[n] = *(const f32x4*)(bW + cB0 + 128 + 4 * n); }
        float muA[4], rsA[4], muB[4], rsB[4]; row_stats4(st, row0, fq, muA, rsA); row_stats4(st, row0 + 128, fq, muB, rsB);
        u32x4 ow[2][4];
#pragma unroll
        for (int ai = 0; ai < 2; ++ai)
#pragma unroll
            for (int m = 0; m < 4; ++m) { const float mu = ai ? muB[m] : muA[m], rs = ai ? rsB[m] : rsA[m]; f32x4 h[2];
#pragma unroll
                for (int n = 0; n < 2; ++n) { const f32x4 zg = (acc[ai][0][m][n] - g0[n] * mu) * rs + b0[n], zu = (acc[ai][1][m][n] - g1[n] * mu) * rs + b1[n]; h[n] = silu_mul(zg, zu); }
                ow[ai][m] = pack8(h[0], h[1]); }
        asm volatile("" ::: "memory");
#pragma unroll
        for (int ai = 0; ai < 2; ++ai)
#pragma unroll
            for (int m = 0; m < 4; ++m) *(u32x4*)(H + blk_off(row0 + ai * 128 + m * 16, u.pn * 128 + cl, FF_)) = ow[ai][m];
    }
};
struct EpiResid {
    static constexpr bool PERM = true, AFTER_DRAIN = false, MIDK = false;
    const float* Yin; float* Y; bf16_t* Yb; const float* stp; float* stn; const float* g; const float* b; float sc;
    __device__ __forceinline__ void operator()(const f32x4 (&acc)[2][2][4][2], const pg8::Unit& u, int wr, int wc, int fr, int fq) const {
        const int row0 = u.pm * 256 + wr * 64 + fr, col0 = u.pn * 256 + wc * 32 + fq * 8;
#pragma unroll
        for (int ai = 0; ai < 2; ++ai) { float mu4[4], rs4[4]; row_stats4(stp, row0 + ai * 128, fq, mu4, rs4);
#pragma unroll
            for (int m = 0; m < 4; ++m) { const int row = row0 + ai * 128 + m * 16; const float mu = mu4[m], rs = rs4[m];
                float s1 = 0.f, s2 = 0.f;
#pragma unroll
                for (int bj = 0; bj < 2; ++bj) { float* yp = Y + (size_t)row * D_ + col0 + bj * 128; const float* yi = Yin + (size_t)row * D_ + col0 + bj * 128; f32x4 v[2];
#pragma unroll
                    for (int n = 0; n < 2; ++n) { const f32x4 yo = *(const f32x4*)(yi + 4 * n), gvv = *(const f32x4*)(g + col0 + bj * 128 + 4 * n), bvv = *(const f32x4*)(b + col0 + bj * 128 + 4 * n); v[n] = (((yo - mu) * rs) * gvv + bvv) * ALPHA_ + acc[ai][bj][m][n] * sc;
                        *(f32x4*)(yp + 4 * n) = v[n]; s1 += (v[n][0] + v[n][1]) + (v[n][2] + v[n][3]); s2 += (v[n][0] * v[n][0] + v[n][1] * v[n][1]) + (v[n][2] * v[n][2] + v[n][3] * v[n][3]); }
                    *(u32x4*)(Yb + blk_off(row, col0 + bj * 128, D_)) = pack8(v[0], v[1]); }
                s1 = xsum32(xsum16(s1)); s2 = xsum32(xsum16(s2));
                if (fq == 0) *(f32x2*)(stn + (size_t)row * 32 + (u.pn * 4 + wc) * 2) = (f32x2){s1, s2}; asm volatile("" ::: "memory"); } }
    }
};
struct EpiProj {
    static constexpr bool PERM = true, AFTER_DRAIN = false, MIDK = false;
    bf16_t* P; const float* st; const float* gW; const float* bW; const float* cosT; const float* sinT;
    __device__ __forceinline__ void operator()(const f32x4 (&acc)[2][2][4][2], const pg8::Unit& u, int wr, int wc, int fr, int fq) const {
        const int row0 = u.pm * 256 + wr * 64 + fr, cl = wc * 32 + fq * 8, cB0 = u.pn * 256 + cl;
        const bool rope = u.pn < 11, qsc = (u.pn < 2) || (u.pn >= 4 && u.pn < 8);
#pragma unroll
        for (int ai = 0; ai < 2; ++ai) { float mu4[4], rs4[4]; row_stats4(st, row0 + ai * 128, fq, mu4, rs4);
#pragma unroll
          for (int mh = 0; mh < 2; ++mh) { f32x4 cv[2][2], sv[2][2];
            if (rope) {
#pragma unroll
                for (int mm = 0; mm < 2; ++mm)
#pragma unroll
                    for (int n = 0; n < 2; ++n) { const size_t ro = (size_t)(row0 + ai * 128 + (2 * mh + mm) * 16) * 32 + fq * 8 + 4 * n; cv[mm][n] = *(const f32x4*)(cosT + ro); sv[mm][n] = *(const f32x4*)(sinT + ro); } }
#pragma unroll
            for (int mm = 0; mm < 2; ++mm) { const int m = 2 * mh + mm; const int row = row0 + ai * 128 + m * 16; const float mu = mu4[m], rs = rs4[m];
                f32x4 g0[2], g1[2], b0[2], b1[2];
#pragma unroll
                for (int n = 0; n < 2; ++n) { g0[n] = *(const f32x4*)(gW + cB0 + 4 * n); g1[n] = *(const f32x4*)(gW + cB0 + 128 + 4 * n); b0[n] = *(const f32x4*)(bW + cB0 + 4 * n); b1[n] = *(const f32x4*)(bW + cB0 + 128 + 4 * n); }
                f32x4 t1[2], t2[2];
#pragma unroll
                for (int n = 0; n < 2; ++n) { t1[n] = (acc[ai][0][m][n] - g0[n] * mu) * rs + b0[n]; t2[n] = (acc[ai][1][m][n] - g1[n] * mu) * rs + b1[n]; }
                bf16_t* pr = P + (size_t)row * NP_ + u.pn * 256;
                if (rope) { f32x4 o1[2], o2[2];
#pragma unroll
                    for (int n = 0; n < 2; ++n) { const f32x4 c = cv[mm][n], s = sv[mm][n];
                        o1[n] = t1[n] * c - t2[n] * s; o2[n] = t2[n] * c + t1[n] * s; }
                    if (qsc) { o1[0] *= SC2_; o1[1] *= SC2_; o2[0] *= SC2_; o2[1] *= SC2_; }
                    *(u32x4*)(pr + wc * 64 + fq * 8) = pack8(o1[0], o1[1]); *(u32x4*)(pr + wc * 64 + 32 + fq * 8) = pack8(o2[0], o2[1]);
                } else { *(u32x4*)(pr + cl) = pack8(t1[0], t1[1]); *(u32x4*)(pr + 128 + cl) = pack8(t2[0], t2[1]); } asm volatile("" ::: "memory"); } } }
    }
};
struct EpiGate {
    static constexpr bool PERM = true, AFTER_DRAIN = false, MIDK = false;
    bf16_t* G; const float* st; const float* gW; const float* bW;
    __device__ __forceinline__ void operator()(const f32x4 (&acc)[2][2][4][2], const pg8::Unit& u, int wr, int wc, int fr, int fq) const {
        const int row0 = u.pm * 256 + wr * 64 + fr, cl = wc * 32 + fq * 8, cB0 = u.pn * 256 + cl;
        f32x4 gg[2][2], bb[2][2];
#pragma unroll
        for (int bj = 0; bj < 2; ++bj)
#pragma unroll
            for (int n = 0; n < 2; ++n) { gg[bj][n] = *(const f32x4*)(gW + cB0 + bj * 128 + 4 * n); bb[bj][n] = *(const f32x4*)(bW + cB0 + bj * 128 + 4 * n); }
        float muA[4], rsA[4], muB[4], rsB[4]; row_stats4(st, row0, fq, muA, rsA); row_stats4(st, row0 + 128, fq, muB, rsB);
#pragma unroll
        for (int ai = 0; ai < 2; ++ai)
#pragma unroll
            for (int m = 0; m < 4; ++m) { const float mu = ai ? muB[m] : muA[m], rs = ai ? rsB[m] : rsA[m];
#pragma unroll
                for (int bj = 0; bj < 2; ++bj) { f32x4 z[2];
#pragma unroll
                    for (int n = 0; n < 2; ++n) { z[n] = (acc[ai][bj][m][n] - gg[bj][n] * mu) * rs + bb[bj][n];
#pragma unroll
                        for (int e = 0; e < 4; ++e) z[n][e] = sigmoid_f(z[n][e]); }
                    *(u32x4*)(G + (size_t)(row0 + ai * 128 + m * 16) * NG_ + cB0 + bj * 128) = pack8(z[0], z[1]); }
                asm volatile("" ::: "memory"); }
    }
};
struct EpiBranch {
    static constexpr bool PERM = true, AFTER_DRAIN = false, MIDK = true;
    const bf16_t* G; bf16_t* Mg;
    __device__ __forceinline__ void mid(f32x4 (&acc)[2][2][4][2], const pg8::Unit& u, int t, int wr, int wc, int fr, int fq) const {
        const int brd = (t >> 3) - 1;
        int fr_ = fr; asm volatile("" : "+v"(fr_));
        const int row0 = u.pm * 256 + wr * 64 + fr_, col0 = u.pn * 256 + wc * 32 + fq * 8;
#pragma unroll
        for (int ai = 0; ai < 2; ++ai)
#pragma unroll
            for (int m = 0; m < 4; ++m) { const bf16_t* gp = G + (size_t)(row0 + ai * 128 + m * 16) * NG_ + brd * 1024 + col0;
#pragma unroll
                for (int bj = 0; bj < 2; ++bj)
#pragma unroll
                    for (int n = 0; n < 2; ++n) { const u32x2 x = *(const u32x2*)(gp + bj * 128 + 4 * n), y = *(const u32x2*)(gp + 1024 + bj * 128 + 4 * n);
                        acc[ai][bj][m][n][0] *= __uint_as_float(x.x << 16) * fast_rcp(fmaxf(__uint_as_float(y.x << 16), 1e-30f)); acc[ai][bj][m][n][1] *= __uint_as_float(x.x & 0xffff0000u) * fast_rcp(fmaxf(__uint_as_float(y.x & 0xffff0000u), 1e-30f));
                        acc[ai][bj][m][n][2] *= __uint_as_float(x.y << 16) * fast_rcp(fmaxf(__uint_as_float(y.y << 16), 1e-30f)); acc[ai][bj][m][n][3] *= __uint_as_float(x.y & 0xffff0000u) * fast_rcp(fmaxf(__uint_as_float(y.y & 0xffff0000u), 1e-30f));
                        asm volatile("" ::: "memory"); } }
    }
    __device__ __forceinline__ void operator()(const f32x4 (&acc)[2][2][4][2], const pg8::Unit& u, int wr, int wc, int fr, int fq) const {
        const int row0 = u.pm * 256 + wr * 64 + fr, col0 = u.pn * 256 + wc * 32 + fq * 8;
        u32x4 gw[2][4][2];
#pragma unroll
        for (int ai = 0; ai < 2; ++ai)
#pragma unroll
            for (int m = 0; m < 4; ++m)
#pragma unroll
                for (int bj = 0; bj < 2; ++bj) gw[ai][m][bj] = *(const u32x4*)(G + (size_t)(row0 + ai * 128 + m * 16) * NG_ + 2048 + col0 + bj * 128);
        asm volatile("" ::: "memory");
#pragma unroll
        for (int ai = 0; ai < 2; ++ai)
#pragma unroll
            for (int m = 0; m < 4; ++m)
#pragma unroll
                for (int bj = 0; bj < 2; ++bj) { f32x4 ga, gb; unpack8(gw[ai][m][bj], ga, gb);
                    *(u32x4*)(Mg + blk_off(row0 + ai * 128 + m * 16, col0 + bj * 128, D_)) = pack8(ga * acc[ai][bj][m][0], gb * acc[ai][bj][m][1]); }
    }
};

#ifndef DSA1_REPS
#define DSA1_REPS 1
#endif
#ifndef DSA3_REPS
#define DSA3_REPS 1
#endif
#define MFMA16(a, b, c) __builtin_amdgcn_mfma_f32_16x16x32_bf16((a), (b), (c), 0, 0, 0)
typedef short v4i16_t __attribute__((ext_vector_type(4)));
__device__ __forceinline__ s16x4 tr_read(LAS unsigned char* p) { return __builtin_bit_cast(s16x4, __builtin_amdgcn_ds_read_tr16_b64_v4i16((LAS v4i16_t*)p)); }
struct KVRegs { bf16x8 ka[2], kb[2]; u32x4 v[4]; };
__device__ __forceinline__ void kv_load(KVRegs& r, const bf16_t* kbase, size_t kst, const bf16_t* vbase, int s, int lane) {
    const int li = lane & 15, g4 = lane >> 4;
    const bf16_t* k0 = kbase + (size_t)(32 * s + li) * kst + 8 * g4;
    r.ka[0] = *(const bf16x8*)k0; r.ka[1] = *(const bf16x8*)(k0 + 32);
    const bf16_t* k1 = k0 + 16 * kst;
    r.kb[0] = *(const bf16x8*)k1; r.kb[1] = *(const bf16x8*)(k1 + 32);
    const bf16_t* vp = vbase + (size_t)(32 * s + (lane >> 1)) * kst + (lane & 1) * 32;
#pragma unroll
    for (int i = 0; i < 4; ++i) r.v[i] = *(const u32x4*)(vp + 8 * i);
}
struct BandMask { int k0, iq, W; __device__ __forceinline__ float operator()(int ko, float s) const { return ((unsigned)(iq - (k0 + ko)) <= (unsigned)W) ? s : -INFINITY; } };
struct SelMask { unsigned w; __device__ __forceinline__ float operator()(int ko, float s) const { const int mk = (int)(w << (31 - ko)) >> 31; return __uint_as_float((__float_as_uint(s) & (unsigned)mk) | (0xff800000u & ~(unsigned)mk)); } };
template <class MaskF>
__device__ __forceinline__ void attn_step(const KVRegs& r, const bf16x8 (&bq)[2], LAS unsigned char* vl, int lane, const MaskF mask, float& m, float& l, f32x4 (&o)[4]) {
    const int g4 = lane >> 4;
    { LAS unsigned char* wp = vl + (lane >> 1) * 128 + (lane & 1) * 64;
#pragma unroll
      for (int i = 0; i < 4; ++i) *(LAS u32x4*)(wp + 16 * i) = r.v[i]; }
    f32x4 sa = (f32x4){0.f, 0.f, 0.f, 0.f}, sb = (f32x4){0.f, 0.f, 0.f, 0.f};
    sa = MFMA16(r.ka[0], bq[0], sa); sa = MFMA16(r.ka[1], bq[1], sa);
    sb = MFMA16(r.kb[0], bq[0], sb); sb = MFMA16(r.kb[1], bq[1], sb);
    float x[8];
#pragma unroll
    for (int e = 0; e < 4; ++e) { x[e] = mask(4 * g4 + e, sa[e]); x[4 + e] = mask(16 + 4 * g4 + e, sb[e]); }
    float tm = fmaxf(fmaxf(fmaxf(x[0], x[1]), fmaxf(x[2], x[3])), fmaxf(fmaxf(x[4], x[5]), fmaxf(x[6], x[7])));
    tm = xmax32(xmax16(tm));
    const float mn = fmaxf(m, tm);
    if (__ballot(mn > m)) { const float al = fast_exp2(m - mn); l *= al;
#pragma unroll
        for (int db = 0; db < 4; ++db) o[db] = o[db] * al; }
    m = mn;
    float p[8], ps = 0.f;
#pragma unroll
    for (int e = 0; e < 8; ++e) { p[e] = fast_exp2(x[e] - mn); ps += p[e]; }
    l += ps;
    u32x4 pw; pw.x = cvt_pk_bf16(p[0], p[1]); pw.y = cvt_pk_bf16(p[2], p[3]); pw.z = cvt_pk_bf16(p[4], p[5]); pw.w = cvt_pk_bf16(p[6], p[7]);
    const bf16x8 pf = __builtin_bit_cast(bf16x8, pw);
    asm volatile("s_waitcnt lgkmcnt(0)" ::: "memory");
    LAS unsigned char* rd = vl + (4 * g4 + ((lane & 15) >> 2)) * 128 + (lane & 3) * 8;
#pragma unroll
    for (int db = 0; db < 4; ++db) { const s16x4 t0 = tr_read(rd + db * 32), t1 = tr_read(rd + 16 * 128 + db * 32);
        const bf16x8 vf = (bf16x8){t0[0], t0[1], t0[2], t0[3], t1[0], t1[1], t1[2], t1[3]};
        o[db] = MFMA16(vf, pf, o[db]); }
    asm volatile("s_waitcnt lgkmcnt(0)" ::: "memory");
}
__device__ __forceinline__ void attn_store(const f32x4 (&o)[4], float inv, bf16_t* op, int g4) {
#pragma unroll
    for (int db = 0; db < 4; ++db) { u32x2 w; w.x = cvt_pk_bf16(o[db][0] * inv, o[db][1] * inv); w.y = cvt_pk_bf16(o[db][2] * inv, o[db][3] * inv); *(u32x2*)(op + 16 * db + 4 * g4) = w; }
}
struct BandGen { int iq, W; __device__ __forceinline__ BandMask operator()(int s) const { return BandMask{32 * s, iq, W}; } };
struct SelGen { const LAS unsigned char* row; __device__ __forceinline__ SelMask operator()(int s) const { return SelMask{*(const LAS unsigned*)(row + 4 * s)}; } };
template <class Gen>
__device__ __forceinline__ void attn_loop(const bf16_t* kbase, size_t kst, const bf16_t* vbase, int s_lo, int s_hi, const bf16x8 (&bq)[2], LAS unsigned char* vl, int lane, const Gen gen, float& m, float& l, f32x4 (&o)[4]) {
    KVRegs kv[4];
    kv_load(kv[0], kbase, kst, vbase, s_lo, lane);
    if (s_lo + 1 <= s_hi) kv_load(kv[1], kbase, kst, vbase, s_lo + 1, lane);
    if (s_lo + 2 <= s_hi) kv_load(kv[2], kbase, kst, vbase, s_lo + 2, lane);
    for (int s = s_lo; s <= s_hi; s += 4) {
#pragma unroll
        for (int j = 0; j < 4; ++j) {
            if (s + j <= s_hi) {
                if (s + j + 3 <= s_hi) kv_load(kv[(j + 3) & 3], kbase, kst, vbase, s + j + 3, lane);
                attn_step(kv[j], bq, vl, lane, gen(s + j), m, l, o);
            }
        }
    }
}
template <int NQ>
__device__ __forceinline__ void band_step(const KVRegs& r, const bf16x8 (&bq)[NQ][2], LAS unsigned char* vl, int lane, int s, int q0, int W, float (&m)[NQ], float (&l)[NQ], f32x4 (&o)[NQ][4]) {
    const int g4 = lane >> 4, qi = lane & 15;
    { LAS unsigned char* wp = vl + (lane >> 1) * 128 + (lane & 1) * 64;
#pragma unroll
      for (int i = 0; i < 4; ++i) *(LAS u32x4*)(wp + 16 * i) = r.v[i]; }
    asm volatile("s_waitcnt lgkmcnt(0)" ::: "memory");
    bf16x8 vf[4];
    { LAS unsigned char* rd = vl + (4 * g4 + (qi >> 2)) * 128 + (lane & 3) * 8;
#pragma unroll
      for (int db = 0; db < 4; ++db) { const s16x4 t0 = tr_read(rd + db * 32), t1 = tr_read(rd + 16 * 128 + db * 32);
          vf[db] = (bf16x8){t0[0], t0[1], t0[2], t0[3], t1[0], t1[1], t1[2], t1[3]}; } }
#pragma unroll
    for (int g = 0; g < NQ; ++g) {
        const int qlo = q0 + 16 * g;
        if (32 * s <= qlo + 15 && 32 * s + 31 >= qlo - W) {
            f32x4 sa = (f32x4){0.f, 0.f, 0.f, 0.f}, sb = (f32x4){0.f, 0.f, 0.f, 0.f};
            sa = MFMA16(r.ka[0], bq[g][0], sa); sa = MFMA16(r.ka[1], bq[g][1], sa);
            sb = MFMA16(r.kb[0], bq[g][0], sb); sb = MFMA16(r.kb[1], bq[g][1], sb);
            const BandMask mask{32 * s, qlo + qi, W};
            float x[8];
#pragma unroll
            for (int e = 0; e < 4; ++e) { x[e] = mask(4 * g4 + e, sa[e]); x[4 + e] = mask(16 + 4 * g4 + e, sb[e]); }
            float tm = fmaxf(fmaxf(fmaxf(x[0], x[1]), fmaxf(x[2], x[3])), fmaxf(fmaxf(x[4], x[5]), fmaxf(x[6], x[7])));
            tm = xmax32(xmax16(tm));
            const float mn = fmaxf(m[g], tm);
            if (__ballot(mn > m[g])) { const float al = fast_exp2(m[g] - mn); l[g] *= al;
#pragma unroll
                for (int db = 0; db < 4; ++db) o[g][db] = o[g][db] * al; }
            m[g] = mn;
            float pp[8], ps = 0.f;
#pragma unroll
            for (int e = 0; e < 8; ++e) { pp[e] = fast_exp2(x[e] - mn); ps += pp[e]; }
            l[g] += ps;
            u32x4 pw; pw.x = cvt_pk_bf16(pp[0], pp[1]); pw.y = cvt_pk_bf16(pp[2], pp[3]); pw.z = cvt_pk_bf16(pp[4], pp[5]); pw.w = cvt_pk_bf16(pp[6], pp[7]);
            const bf16x8 pf = __builtin_bit_cast(bf16x8, pw);
#pragma unroll
            for (int db = 0; db < 4; ++db) o[g][db] = MFMA16(vf[db], pf, o[g][db]);
        }
    }
}
template <int NQ>
__device__ __forceinline__ void band_unit(int u, const bf16_t* P, bf16_t* OB, bf16_t* ACX, float* LSE, const float* sink, LAS unsigned char* vl, int lane_in) {
    int lane = lane_in; asm volatile("" : "+v"(lane));
    constexpr int UQ = 16 * NQ, TPS = SEQ_ / UQ, UPC = NB_ * 8 * TPS;
    const int cfg = u / UPC, rr = u % UPC, b = rr / (8 * TPS), h = (rr / TPS) & 7, ts = rr % TPS;
    const int d = (cfg == 1) ? 4 : (cfg == 2) ? 16 : 1, tpc = TPS / d, cls = ts / tpc, it = ts % tpc, q0 = UQ * it, W = (cfg == 3) ? 127 : 128;
    const int qcol = (cfg < 3) ? PC_QA + h * 64 : PC_QB + h * 64, kcol = (cfg < 3) ? PC_KA + h * 64 : PC_KB + (h >> 2) * 64, vcol = (cfg < 3) ? PC_VA + h * 64 : PC_VB + (h >> 2) * 64;
    const size_t rowbase = (size_t)b * SEQ_ + cls, kst = (size_t)d * NP_;
    const bf16_t* kbase = P + rowbase * NP_ + kcol; const bf16_t* vbase = P + rowbase * NP_ + vcol;
    const int qi = lane & 15, g4 = lane >> 4;
    bf16x8 bq[NQ][2]; float m[NQ], l[NQ]; f32x4 o[NQ][4];
#pragma unroll
    for (int g = 0; g < NQ; ++g) { const bf16_t* qp = P + (rowbase + (size_t)d * (q0 + 16 * g + qi)) * NP_ + qcol + 8 * g4; bq[g][0] = *(const bf16x8*)qp; bq[g][1] = *(const bf16x8*)(qp + 32);
        m[g] = -1e30f; l[g] = 0.f; if (cfg == 3) { m[g] = sink[h] * 1.4426950408889634f; l[g] = (g4 == 0) ? 1.f : 0.f; }
#pragma unroll
        for (int db = 0; db < 4; ++db) o[g][db] = (f32x4){0.f, 0.f, 0.f, 0.f}; }
    const int s_hi = (q0 + UQ - 1) >> 5, s_lo = (q0 >= 128) ? ((q0 - 128) >> 5) : 0;
    constexpr int RING = (NQ > 2) ? 2 : 3;
    KVRegs kv[RING];
    kv_load(kv[0], kbase, kst, vbase, s_lo, lane);
    if (RING > 2 && s_lo + 1 <= s_hi) kv_load(kv[1], kbase, kst, vbase, s_lo + 1, lane);
    for (int s = s_lo; s <= s_hi; s += RING) {
#pragma unroll
        for (int j = 0; j < RING; ++j) {
            if (s + j <= s_hi) {
                if (s + j + RING - 1 <= s_hi) kv_load(kv[(j + RING - 1) % RING], kbase, kst, vbase, s + j + RING - 1, lane);
                band_step<NQ>(kv[j], bq, vl, lane, s + j, q0, W, m, l, o);
            }
        }
    }
#pragma unroll
    for (int g = 0; g < NQ; ++g) {
        const size_t tq = rowbase + (size_t)d * (q0 + 16 * g + qi);
        float lt = l[g]; lt = xsum32(xsum16(lt));
        bf16_t* op = (cfg == 0) ? OB + tq * NO_ + h * 64 : (cfg == 3) ? OB + tq * NO_ + 512 + h * 64 : ACX + (size_t)(cfg - 1) * T_ * 512 + tq * 512 + h * 64;
        attn_store(o[g], fast_rcp(lt), op, g4);
        if (cfg < 3 && g4 == 0) LSE[(size_t)cfg * T_ * 8 + tq * 8 + h] = m[g] + __log2f(lt);
    }
}
template <class MaskF>
__device__ __forceinline__ void attn_step_lds(const LAS unsigned char* kl, LAS unsigned char* vl, const bf16x8 (&bq)[2], int lane, const MaskF mask, float& m, float& l, f32x4 (&o)[4]) {
    const int g4 = lane >> 4, li = lane & 15;
    const LAS unsigned char* kp = kl + li * 144 + 16 * g4;
    const bf16x8 ka0 = *(const LAS bf16x8*)kp, ka1 = *(const LAS bf16x8*)(kp + 64), kb0 = *(const LAS bf16x8*)(kp + 16 * 144), kb1 = *(const LAS bf16x8*)(kp + 16 * 144 + 64);
    f32x4 sa = (f32x4){0.f, 0.f, 0.f, 0.f}, sb = (f32x4){0.f, 0.f, 0.f, 0.f};
    sa = MFMA16(ka0, bq[0], sa); sa = MFMA16(ka1, bq[1], sa);
    sb = MFMA16(kb0, bq[0], sb); sb = MFMA16(kb1, bq[1], sb);
    LAS unsigned char* rd = vl + (4 * g4 + (li >> 2)) * 128 + (lane & 3) * 8;
    s16x4 t0[4], t1[4];
#pragma unroll
    for (int db = 0; db < 4; ++db) { t0[db] = tr_read(rd + db * 32); t1[db] = tr_read(rd + 16 * 128 + db * 32); }
    float x[8];
#pragma unroll
    for (int e = 0; e < 4; ++e) { x[e] = mask(4 * g4 + e, sa[e]); x[4 + e] = mask(16 + 4 * g4 + e, sb[e]); }
    float tm = fmaxf(fmaxf(fmaxf(x[0], x[1]), fmaxf(x[2], x[3])), fmaxf(fmaxf(x[4], x[5]), fmaxf(x[6], x[7])));
    tm = xmax32(xmax16(tm));
    const float mn = fmaxf(m, tm);
    if (__ballot(mn > m)) { const float al = fast_exp2(m - mn); l *= al;
#pragma unroll
        for (int db = 0; db < 4; ++db) o[db] = o[db] * al; }
    m = mn;
    float p[8], ps = 0.f;
#pragma unroll
    for (int e = 0; e < 8; ++e) { p[e] = fast_exp2(x[e] - mn); ps += p[e]; }
    l += ps;
    u32x4 pw; pw.x = cvt_pk_bf16(p[0], p[1]); pw.y = cvt_pk_bf16(p[2], p[3]); pw.z = cvt_pk_bf16(p[4], p[5]); pw.w = cvt_pk_bf16(p[6], p[7]);
    const bf16x8 pf = __builtin_bit_cast(bf16x8, pw);
#pragma unroll
    for (int db = 0; db < 4; ++db) { const bf16x8 vf = (bf16x8){t0[db][0], t0[db][1], t0[db][2], t0[db][3], t1[db][0], t1[db][1], t1[db][2], t1[db][3]};
        o[db] = MFMA16(vf, pf, o[db]); }
}
constexpr int C_SCW = 4112, C_IDX = 16 * C_SCW, C_CNT = C_IDX + 16 * 512, C_VT = C_CNT + 64, C_VST = 0, C_LDS_END = C_VT + 8 * 4096;
__device__ __forceinline__ unsigned f16key(unsigned h) { return (h & 0x8000u) ? (~h & 0xffffu) : (h | 0x8000u); }
__device__ __forceinline__ unsigned wave_sum_u32(unsigned c) {
    c += (unsigned)__builtin_amdgcn_update_dpp(0, (int)c, 0x128, 0xf, 0xf, false);
    c += (unsigned)__builtin_amdgcn_update_dpp(0, (int)c, 0x124, 0xf, 0xf, false);
    c += (unsigned)__builtin_amdgcn_update_dpp(0, (int)c, 0x122, 0xf, 0xf, false);
    c += (unsigned)__builtin_amdgcn_update_dpp(0, (int)c, 0x121, 0xf, 0xf, false);
    { const auto r = __builtin_amdgcn_permlane16_swap(c, c, false, false); c = r[0] + r[1]; }
    { const auto r = __builtin_amdgcn_permlane32_swap(c, c, false, false); c = r[0] + r[1]; }
    return c;
}
template <int NJ>
__device__ __forceinline__ void dsa_select(LAS unsigned char* lds, int qs, int t, int lane) {
    unsigned v[NJ];
#pragma unroll
    for (int j = 0; j < NJ; ++j) { const int key = 64 * j + lane; const unsigned raw = *(const LAS unsigned short*)(lds + qs * C_SCW + key * 2); v[j] = (key <= t) ? f16key(raw) : 0u; }
    unsigned theta = 1u; int need = t + 1;
    if (t + 1 > 256) {
        need = 256; theta = 0u;
        for (int bit = 15; bit >= 0; --bit) { const unsigned tr = theta | (1u << bit); unsigned c = 0u;
#pragma unroll
            for (int j = 0; j < NJ; ++j) c += (v[j] >= tr) ? 1u : 0u;
            c = wave_sum_u32(c);
            theta = (c >= 256u) ? tr : theta; }
        theta = (unsigned)__builtin_amdgcn_readfirstlane((int)theta);
    }
    int cgt = 0;
#pragma unroll
    for (int j = 0; j < NJ; ++j) cgt += __popcll(__ballot(v[j] > theta));
    const int rem = need - cgt; int taken = 0, base = 0;
    LAS unsigned short* il = (LAS unsigned short*)(lds + C_IDX + qs * 512);
#pragma unroll
    for (int j = 0; j < NJ; ++j) {
        const bool eq = (v[j] == theta);
        const unsigned long long tmask = __ballot(eq);
        const int rank = (int)__builtin_amdgcn_mbcnt_hi((unsigned)(tmask >> 32), __builtin_amdgcn_mbcnt_lo((unsigned)tmask, 0u)) + taken;
        const bool sel = (v[j] > theta) || (eq && rank < rem);
        const unsigned long long smask = __ballot(sel);
        taken += __popcll(tmask);
        const int pos = base + (int)__builtin_amdgcn_mbcnt_hi((unsigned)(smask >> 32), __builtin_amdgcn_mbcnt_lo((unsigned)smask, 0u));
        if (sel) il[pos] = (unsigned short)(64 * j + lane);
        base += __popcll(smask);
    }
#pragma unroll
    for (int i = 0; i < 4; ++i) { const int pos = base + lane + 64 * i; if (pos < 256) il[pos] = 0; }
    if (lane == 0) *(LAS int*)(lds + C_CNT + qs * 4) = base;
}
struct CountMask { int s32, cnt; __device__ __forceinline__ float operator()(int ko, float s) const { return (s32 + ko < cnt) ? s : -INFINITY; } };
__device__ __forceinline__ void kv_gather(KVRegs& r, const bf16_t* Pb, const LAS unsigned short* il, int s, int lane) {
    const int li = lane & 15, g4 = lane >> 4;
    const unsigned ra = il[32 * s + li], rb = il[32 * s + 16 + li], rv = il[32 * s + (lane >> 1)];
    const bf16_t* k0 = Pb + (size_t)ra * NP_ + PC_KC + 8 * g4; const bf16_t* k1 = Pb + (size_t)rb * NP_ + PC_KC + 8 * g4;
    r.ka[0] = *(const bf16x8*)k0; r.ka[1] = *(const bf16x8*)(k0 + 32); r.kb[0] = *(const bf16x8*)k1; r.kb[1] = *(const bf16x8*)(k1 + 32);
    const bf16_t* vp = Pb + (size_t)rv * NP_ + PC_VC + (lane & 1) * 32;
#pragma unroll
    for (int i = 0; i < 4; ++i) r.v[i] = *(const u32x4*)(vp + 8 * i);
}
__device__ __forceinline__ void dsa_unit(int b, int blk, const bf16_t* P, bf16_t* OB, LAS unsigned char* lds, int wave, int tid_in) {
    int tid = tid_in; asm volatile("" : "+v"(tid));
    const int lane = tid & 63;
    const int t0 = blk * 16, nk = t0 + 16; const size_t tok0 = (size_t)b * SEQ_;
    const int qi = lane & 15, g4 = lane >> 4;
    const bf16_t* qrow = P + (tok0 + t0 + qi) * NP_;
    {
        bf16x8 bqi[8][2]; float w[8];
#pragma unroll
        for (int h = 0; h < 8; ++h) { bqi[h][0] = *(const bf16x8*)(qrow + PC_QI + h * 64 + 8 * g4); bqi[h][1] = *(const bf16x8*)(qrow + PC_QI + h * 64 + 32 + 8 * g4); }
        { const u32x4 ww = *(const u32x4*)(qrow + PC_WI); f32x4 wa, wb; unpack8(ww, wa, wb);
#pragma unroll
          for (int e = 0; e < 4; ++e) { w[e] = wa[e]; w[4 + e] = wb[e]; } }
        const int ntile = nk >> 4;
        const bf16_t* kp0 = P + (tok0 + qi) * NP_ + PC_KI + 8 * g4;
        bf16x8 kf[6][2];
#pragma unroll
        for (int i = 0; i < 5; ++i) if (wave + 8 * i < ntile) { const bf16_t* kp = kp0 + (size_t)(16 * (wave + 8 * i)) * NP_; kf[i][0] = *(const bf16x8*)kp; kf[i][1] = *(const bf16x8*)(kp + 32); }
        for (int kt = wave; kt < ntile; kt += 48) {
#pragma unroll
            for (int j = 0; j < 6; ++j) {
                const int kc = kt + 8 * j;
                if (kc < ntile) {
                    if (kc + 40 < ntile) { const bf16_t* kp = kp0 + (size_t)(16 * (kc + 40)) * NP_; kf[(j + 5) % 6][0] = *(const bf16x8*)kp; kf[(j + 5) % 6][1] = *(const bf16x8*)(kp + 32); }
                    f32x4 sc = (f32x4){0.f, 0.f, 0.f, 0.f};
#pragma unroll
                    for (int h = 0; h < 8; ++h) { f32x4 s = (f32x4){0.f, 0.f, 0.f, 0.f}; s = MFMA16(kf[j][0], bqi[h][0], s); s = MFMA16(kf[j][1], bqi[h][1], s);
#pragma unroll
                        for (int e = 0; e < 4; ++e) sc[e] = fmaf(w[h], fmaxf(s[e], 0.f), sc[e]); }
                    u32x2 o2;
                    { const _Float16 h0 = (_Float16)sc[0], h1 = (_Float16)sc[1], h2 = (_Float16)sc[2], h3 = (_Float16)sc[3];
                      o2.x = (unsigned)__builtin_bit_cast(unsigned short, h0) | ((unsigned)__builtin_bit_cast(unsigned short, h1) << 16);
                      o2.y = (unsigned)__builtin_bit_cast(unsigned short, h2) | ((unsigned)__builtin_bit_cast(unsigned short, h3) << 16); }
                    *(LAS u32x2*)(lds + qi * C_SCW + (16 * kc + 4 * g4) * 2) = o2;
                }
            }
        }
    }
    __syncthreads();
    {
        const int nj = (nk + 63) >> 6;
        for (int qq = 0; qq < 2; ++qq) {
            const int qs = wave * 2 + qq, t = t0 + qs;
            if (nj <= 8) dsa_select<8>(lds, qs, t, lane); else if (nj <= 16) dsa_select<16>(lds, qs, t, lane); else if (nj <= 24) dsa_select<24>(lds, qs, t, lane); else dsa_select<32>(lds, qs, t, lane);
        }
    }
    __syncthreads();
    {
        const bf16_t* Pb = P + tok0 * NP_;
        LAS unsigned char* vl = lds + C_VT + wave * 4096;
        const int col = lane & 15;
        for (int qq = 0; qq < 2; ++qq) {
            const int qs = wave * 2 + qq;
            const LAS unsigned short* il = (const LAS unsigned short*)(lds + C_IDX + qs * 512);
            const int cnt = *(const LAS int*)(lds + C_CNT + qs * 4);
            bf16x8 bq[2];
            { const bf16_t* qp = P + (tok0 + t0 + qs) * NP_ + PC_QC + (col & 7) * 64 + 8 * g4; bq[0] = *(const bf16x8*)qp; bq[1] = *(const bf16x8*)(qp + 32);
              if (col >= 8) { bq[0] = (bf16x8){0, 0, 0, 0, 0, 0, 0, 0}; bq[1] = bq[0]; } }
            float m = -1e30f, l = 0.f; f32x4 o[4];
#pragma unroll
            for (int db = 0; db < 4; ++db) o[db] = (f32x4){0.f, 0.f, 0.f, 0.f};
            const int s_hi = ((cnt + 31) >> 5) - 1;
            KVRegs kv[2];
            kv_gather(kv[0], Pb, il, 0, lane);
            for (int s = 0; s <= s_hi; s += 2) {
#pragma unroll
                for (int j = 0; j < 2; ++j) {
                    if (s + j <= s_hi) {
                        if (s + j + 1 <= s_hi) kv_gather(kv[(j + 1) % 2], Pb, il, s + j + 1, lane);
                        attn_step(kv[j], bq, vl, lane, CountMask{32 * (s + j), cnt}, m, l, o);
                    }
                }
            }
            float lt = l; lt = xsum32(xsum16(lt));
            if (col < 8) attn_store(o, fast_rcp(lt), OB + (tok0 + t0 + qs) * NO_ + 1024 + col * 64, g4);
        }
    }
    __syncthreads();
}

__device__ __forceinline__ void prep_load(f32x4 (&r)[8], const float* W, int N_src, int k0, int src_col, bool cv, int lane) {
    const float* p = W + (size_t)(k0 + (lane >> 3)) * N_src + src_col + 4 * (lane & 7);
#pragma unroll
    for (int i = 0; i < 8; ++i) r[i] = cv ? *(const f32x4*)(p + (size_t)(8 * i) * N_src) : (f32x4){0.f, 0.f, 0.f, 0.f};
}
__device__ __forceinline__ void prep_chunk(const f32x4 (&r)[8], int k0, int ldd, const float* g, const float* b, bf16_t* dst, LAS float* scr, int lane, f32x4& sg, f32x4& sb) {
    const int c4 = lane & 7, r8 = lane >> 3;
#pragma unroll
    for (int i = 0; i < 8; ++i) { const int row = r8 + 8 * i; const float gv = g ? g[k0 + row] : 1.f, bv = b ? b[k0 + row] : 0.f; f32x4 wr;
#pragma unroll
        for (int e = 0; e < 4; ++e) { wr[e] = bf2f(f2bf(r[i][e] * gv)); scr[row * 33 + 4 * c4 + e] = wr[e]; }
        sg += wr; sb += r[i] * bv; }
    asm volatile("s_waitcnt lgkmcnt(0)" ::: "memory");
    const int c = lane & 7;
#pragma unroll
    for (int j = 0; j < 4; ++j) { const int nn = (lane >> 3) + 8 * j; const LAS float* s = scr + (8 * c) * 33 + nn;
        u32x4 o; o.x = (f2bf(s[0]) | (f2bf(s[33]) << 16)); o.y = (f2bf(s[66]) | (f2bf(s[99]) << 16)); o.z = (f2bf(s[132]) | (f2bf(s[165]) << 16)); o.w = (f2bf(s[198]) | (f2bf(s[231]) << 16));
        *(u32x4*)(dst + (size_t)nn * ldd + k0 + 8 * c) = o; }
    asm volatile("s_waitcnt lgkmcnt(0)" ::: "memory");
}
__device__ __forceinline__ void prep_item(const float* W, int N_src, int ldd, int kbeg, int kend, int src_col, int nvalid, const float* g, const float* b, bf16_t* dst, float* gWo, float* bWo, LAS float* scr, int lane_in) {
    int lane = lane_in; asm volatile("" : "+v"(lane));
    const bool cv = 4 * (lane & 7) < nvalid;
    f32x4 sg = (f32x4){0.f, 0.f, 0.f, 0.f}, sb = (f32x4){0.f, 0.f, 0.f, 0.f};
    f32x4 ra[8], rb[8];
    prep_load(ra, W, N_src, kbeg, src_col, cv, lane);
    for (int k0 = kbeg; k0 < kend; k0 += 128) {
        if (k0 + 64 < kend) prep_load(rb, W, N_src, k0 + 64, src_col, cv, lane);
        prep_chunk(ra, k0, ldd, g, b, dst, scr, lane, sg, sb);
        if (k0 + 64 < kend) {
            if (k0 + 128 < kend) prep_load(ra, W, N_src, k0 + 128, src_col, cv, lane);
            prep_chunk(rb, k0 + 64, ldd, g, b, dst, scr, lane, sg, sb);
        }
    }
    if (gWo) {
#pragma unroll
        for (int e = 0; e < 4; ++e) { sg[e] += __shfl_xor(sg[e], 8); sg[e] += __shfl_xor(sg[e], 16); sg[e] += __shfl_xor(sg[e], 32); sb[e] += __shfl_xor(sb[e], 8); sb[e] += __shfl_xor(sb[e], 16); sb[e] += __shfl_xor(sb[e], 32); }
        if (lane < 8) { *(f32x4*)(gWo + 4 * lane) = sg; *(f32x4*)(bWo + 4 * lane) = sb; }
    }
}
__device__ __forceinline__ int proj_src(int G, int& nvalid) {
    const int pn = G >> 3, gi = G & 7; nvalid = 32;
    if (pn < 11) { const int bj = gi >> 2, wc = gi & 3; int hb;
        if (pn < 2) hb = SC_QA + (4 * pn + wc) * 64; else if (pn < 4) hb = SC_KA + (4 * (pn - 2) + wc) * 64; else if (pn < 6) hb = SC_QB + (4 * (pn - 4) + wc) * 64;
        else if (pn < 8) hb = SC_QC + (4 * (pn - 6) + wc) * 64; else if (pn < 10) hb = SC_QI + (4 * (pn - 8) + wc) * 64;
        else hb = (wc == 0) ? SC_KB : (wc == 1) ? SC_KB + 64 : (wc == 2) ? SC_KC : SC_KI;
        return hb + 32 * bj; }
    if (pn < 13) return SC_VA + (pn - 11) * 256 + 32 * gi;
    if (gi < 4) return SC_VB + 32 * gi;
    if (gi < 6) return SC_VC + 32 * (gi - 4);
    if (gi == 6) { nvalid = 8; return SC_WI; }
    nvalid = 0; return 0;
}
constexpr int PREP_ITEMS = 176 + 128 + 112 + 96 + 96 + 32 + 176 + 128;
struct Ptrs {
    const float *x, *w_in, *sink, *w_out, *f1i, *f1o, *f2i, *f2o, *lng, *lnb; const int* pos;
    float *Y, *stats, *cosT, *sinT, *ones, *zeros, *aux, *LSE; bf16_t *Yb, *Wb, *BIG, *OB, *ACX;
};
__device__ __forceinline__ void prep_layer(const Ptrs& p, const float* const* inp, int l, LAS unsigned char* lds, int gw, int ngw, int wave, int lane) {
    LAS float* scr = (LAS float*)(lds + wave * 8448);
    const float* g_prev = (l == 0) ? nullptr : p.lng + (size_t)((l - 1) * 3 + 2) * D_; const float* b_prev = (l == 0) ? nullptr : p.lnb + (size_t)((l - 1) * 3 + 2) * D_;
    const float* g0 = p.lng + (size_t)(l * 3 + 0) * D_; const float* b0 = p.lnb + (size_t)(l * 3 + 0) * D_;
    const float* g1 = p.lng + (size_t)(l * 3 + 1) * D_; const float* b1 = p.lnb + (size_t)(l * 3 + 1) * D_;
    for (int it = gw; it < PREP_ITEMS; it += ngw) {
        int r = it;
        const float* W; int N_src, K, kbeg = 0, kend, src, nv = 32; const float* g = nullptr; const float* b = nullptr; bf16_t* dst; float* gWo = nullptr; float* bWo = nullptr;
        if (r < 176) { const int j = r >> 3, gi = r & 7; src = (gi < 4) ? 128 * j + 32 * gi : FF_ + 128 * j + 32 * (gi - 4);
            W = p.f1i + (size_t)l * D_ * 2 * FF_; N_src = 2 * FF_; K = D_; kend = D_; g = g_prev; b = b_prev; dst = p.Wb + WE_1 + (size_t)r * 32 * D_; gWo = p.aux + AUX_G1 + r * 32; bWo = p.aux + AUX_B1 + r * 32; }
        else if ((r -= 176) < 128) { const int rg = r >> 2, kq = r & 3; W = p.f1o + (size_t)l * FF_ * D_; N_src = D_; K = FF_; kbeg = 704 * kq; kend = kbeg + 704; src = 32 * rg; dst = p.Wb + WE_2 + (size_t)rg * 32 * FF_; }
        else if ((r -= 128) < 112) { src = proj_src(r, nv); W = p.w_in + (size_t)l * D_ * DIN_; N_src = DIN_; K = D_; kend = D_; g = g0; b = b0; dst = p.Wb + WE_3 + (size_t)r * 32 * D_; gWo = p.aux + AUX_G3 + r * 32; bWo = p.aux + AUX_B3 + r * 32; }
        else if ((r -= 112) < 96) { src = SC_G + 32 * r; W = p.w_in + (size_t)l * D_ * DIN_; N_src = DIN_; K = D_; kend = D_; g = g0; b = b0; dst = p.Wb + WE_4 + (size_t)r * 32 * D_; gWo = p.aux + AUX_G4 + r * 32; bWo = p.aux + AUX_B4 + r * 32; }
        else if ((r -= 96) < 96) { const int br = r >> 5; W = inp[4 + br] + (size_t)l * 512 * D_; N_src = D_; K = 1536; kend = 512; src = 32 * (r & 31); dst = p.Wb + WE_5 + (size_t)(32 * (r & 31)) * 1536 + br * 512; }
        else if ((r -= 96) < 32) { W = p.w_out + (size_t)l * D_ * D_; N_src = D_; K = D_; kend = D_; src = 32 * r; dst = p.Wb + WE_6 + (size_t)r * 32 * D_; }
        else if ((r -= 32) < 176) { const int j = r >> 3, gi = r & 7; src = (gi < 4) ? 128 * j + 32 * gi : FF_ + 128 * j + 32 * (gi - 4);
            W = p.f2i + (size_t)l * D_ * 2 * FF_; N_src = 2 * FF_; K = D_; kend = D_; g = g1; b = b1; dst = p.Wb + WE_7 + (size_t)r * 32 * D_; gWo = p.aux + AUX_G7 + r * 32; bWo = p.aux + AUX_B7 + r * 32; }
        else { r -= 176; const int rg = r >> 2, kq = r & 3; W = p.f2o + (size_t)l * FF_ * D_; N_src = D_; K = FF_; kbeg = 704 * kq; kend = kbeg + 704; src = 32 * rg; dst = p.Wb + WE_8 + (size_t)rg * 32 * FF_; }
        prep_item(W, N_src, K, kbeg, kend, src, nv, g, b, dst, gWo, bWo, scr, lane);
    }
}
__device__ const double ROPE_INV[32] = {1.0, 0.7498942093324559, 0.5623413251903491, 0.4216965034285822, 0.31622776601683794, 0.23713737056616552, 0.1778279410038923, 0.1333521432163324, 0.1, 0.07498942093324558, 0.05623413251903491, 0.042169650342858224, 0.03162277660168379, 0.023713737056616554, 0.01778279410038923, 0.01333521432163324, 0.01, 0.007498942093324558, 0.005623413251903491, 0.004216965034285823, 0.0031622776601683794, 0.0023713737056616554, 0.0017782794100389228, 0.001333521432163324, 0.001, 0.0007498942093324559, 0.0005623413251903491, 0.00042169650342858224, 0.00031622776601683794, 0.00023713737056616554, 0.00017782794100389227, 0.0001333521432163324};
__device__ __forceinline__ double rope_inv(int i) { return ROPE_INV[i]; }
__device__ __forceinline__ void prologue(const Ptrs& p, int gtid, int ngt) {
    for (size_t c = gtid; c < (size_t)T_ * D_ / 8; c += ngt) { const f32x4 a = *(const f32x4*)(p.x + c * 8), b = *(const f32x4*)(p.x + c * 8 + 4);
        *(u32x4*)(p.Yb + blk_off((int)(c >> 7), (int)(c & 127) * 8, D_)) = pack8(a, b); }
    for (size_t c = gtid; c < (size_t)T_ * 8; c += ngt) { f32x4 v = (f32x4){0.f, 0.f, 0.f, 0.f}; if ((c & 7) == 0) v[1] = 1024.0f * (1.0f - LN_EPS_); *(f32x4*)(p.stats + (size_t)T_ * 32 + c * 4) = v; }
    for (size_t c = gtid; c < (size_t)T_ * 32; c += ngt) { const int t = (int)(c >> 5), i = (int)(c & 31); const double ang = (double)p.pos[t] * rope_inv(i);
        const double rev = ang * 0.15915494309189535; const double fr = rev - rint(rev); const float r = (float)(fr * 6.283185307179586);
        p.cosT[c] = __cosf(r); p.sinT[c] = __sinf(r); }
    for (int c = gtid; c < D_; c += ngt) { p.ones[c] = 1.f; p.zeros[c] = 0.f; }
}
__device__ __forceinline__ void combine_a(const Ptrs& p, int gtid, int ngt) {
    for (size_t c = gtid; c < (size_t)T_ * 64; c += ngt) { const size_t t = c >> 6; const int j = (int)(c & 63), h = j >> 3;
        const float L0 = p.LSE[t * 8 + h], L1 = p.LSE[(size_t)T_ * 8 + t * 8 + h], L2 = p.LSE[(size_t)2 * T_ * 8 + t * 8 + h];
        const float mx = fmaxf(L0, fmaxf(L1, L2)); float w0 = fast_exp2(L0 - mx), w1 = fast_exp2(L1 - mx), w2 = fast_exp2(L2 - mx); const float inv = fast_rcp(w0 + w1 + w2); w0 *= inv; w1 *= inv; w2 *= inv;
        bf16_t* o0 = p.OB + t * NO_ + j * 8; const bf16_t* o1 = p.ACX + t * 512 + j * 8; const bf16_t* o2 = p.ACX + (size_t)T_ * 512 + t * 512 + j * 8;
        f32x4 a0, b0, a1, b1, a2, b2; unpack8(*(const u32x4*)o0, a0, b0); unpack8(*(const u32x4*)o1, a1, b1); unpack8(*(const u32x4*)o2, a2, b2);
        *(u32x4*)o0 = pack8(a0 * w0 + a1 * w1 + a2 * w2, b0 * w0 + b1 * w1 + b2 * w2); }
}
__device__ __forceinline__ void final_ln(const Ptrs& p, const float* st, const float* g, const float* b, int gw, int ngw, int lane) {
    for (int row = gw; row < T_; row += ngw) { float mu, rs; row_stats(st, row, lane >> 4, mu, rs);
#pragma unroll
        for (int j = 0; j < 4; ++j) { float* yp = p.Y + (size_t)row * D_ + 256 * j + 4 * lane; const f32x4 v = *(const f32x4*)yp, gg = *(const f32x4*)(g + 256 * j + 4 * lane), bb = *(const f32x4*)(b + 256 * j + 4 * lane);
            *(f32x4*)yp = ((v - mu) * rs) * gg + bb; } }
}


typedef unsigned short bf16;
#define XB_TMO      128
#define XB_XCNT(j)  (256  + 64 * (j))
#define XB_XSUB(j)  (1280 + 64 * (j))
#define XB_XGEN(j)  (2304 + 64 * (j))
#define XB_TOP      3328
#define XB_TOPGEN   3392
#define XCD_BAR_WORDS 3456
#define XB_SPIN_CAP (1u << 18)

__device__ __forceinline__ unsigned xb_ld(unsigned* p)              { return __hip_atomic_load(p, __ATOMIC_RELAXED, __HIP_MEMORY_SCOPE_AGENT); }
__device__ __forceinline__ unsigned xb_add(unsigned* p, unsigned v) { return __hip_atomic_fetch_add(p, v, __ATOMIC_RELAXED, __HIP_MEMORY_SCOPE_AGENT); }
__device__ __forceinline__ unsigned xb_xcc_id() { return (unsigned)__builtin_amdgcn_s_getreg((3 << 11) | 20) & 0xFu; }
#define XB_SPIN(cond, bar) do { unsigned _sp = 0; while (cond) { __builtin_amdgcn_s_sleep(1); \
    if ((++_sp & 255u) == 0u) { if (xb_ld(&(bar)[XB_TMO])) break; if (_sp > XB_SPIN_CAP) { atomicAdd(&(bar)[XB_TMO], 1u); break; } } } } while (0)

struct XcdBarrier {
    unsigned* bar; unsigned x;
    volatile LAS unsigned* st;
};

__device__ __forceinline__ XcdBarrier xcd_barrier_post(unsigned* bar, volatile LAS unsigned* st) {
    XcdBarrier b; b.bar = bar; b.x = xb_xcc_id(); b.st = st;
    if (threadIdx.x == 0) (void)xb_add(&bar[XB_XCNT(b.x)], 1u);
    return b;
}
__device__ __forceinline__ void xcd_barrier_complete(unsigned* bar, unsigned x, unsigned& nloc, unsigned& nx) {
    const unsigned G = gridDim.x * gridDim.y * gridDim.z;
    unsigned sum, cnt, mine, sp = 0u;
    for (;;) {
        sum = 0u; cnt = 0u; mine = 0u;
#pragma unroll
        for (unsigned j = 0; j < 16; ++j) { const unsigned c = xb_ld(&bar[XB_XCNT(j)]); sum += c; cnt += (c > 0u) ? 1u : 0u; mine = (j == x) ? c : mine; }
        if (sum == G) break;
        __builtin_amdgcn_s_sleep(1);
        if ((++sp & 255u) == 0u) { if (xb_ld(&bar[XB_TMO])) break; if (sp > XB_SPIN_CAP) { atomicAdd(&bar[XB_TMO], 1u); break; } }
    }
    nloc = mine > 0u ? mine : 1u; nx = cnt > 0u ? cnt : 1u;
}

__device__ __forceinline__ void xcd_barrier(const XcdBarrier& b) {
    asm volatile("s_waitcnt vmcnt(0)" ::: "memory");
    __syncthreads();
    if (threadIdx.x == 0) {
        unsigned* bar = b.bar;
        __builtin_amdgcn_s_waitcnt(0);
        unsigned nloc = b.st[0], nx = b.st[1];
        if (nloc == 0u) { xcd_barrier_complete(bar, b.x, nloc, nx); b.st[0] = nloc; b.st[1] = nx; }
        const unsigned old = xb_add(&bar[XB_XSUB(b.x)], 1u);
        const unsigned gen = old / nloc;
        if (old + 1u == (gen + 1u) * nloc) {
            __builtin_amdgcn_fence(__ATOMIC_RELEASE, "agent");
            asm volatile("s_waitcnt vmcnt(0)" ::: "memory");
            const unsigned og = xb_add(&bar[XB_TOP], 1u);
            const unsigned tg = og / nx;
            if (og + 1u == (tg + 1u) * nx) xb_add(&bar[XB_TOPGEN], 1u);
            else XB_SPIN(xb_ld(&bar[XB_TOPGEN]) == tg, bar);
            __builtin_amdgcn_fence(__ATOMIC_ACQUIRE, "agent");
            xb_add(&bar[XB_XGEN(b.x)], 1u);
            asm volatile("s_waitcnt vmcnt(0)" ::: "memory");
        } else {
            XB_SPIN(xb_ld(&bar[XB_XGEN(b.x)]) == gen, bar);
            __builtin_amdgcn_fence(__ATOMIC_ACQUIRE, "agent");
            asm volatile("s_waitcnt vmcnt(0)" ::: "memory");
        }
    }
    __syncthreads();
}

constexpr int NWAVES = 8, LDS_BYTES = 131072 + 256, LDS_MISC = 131072;
constexpr size_t WS_CTL = 16 * MiB + 512 * 1024, CTL_BYTES = 16384;
#ifndef DSA_REPS
#define DSA_REPS 1
#endif
#ifndef BAND_REPS
#define BAND_REPS 1
#endif
#ifndef BAND_NQ
#define BAND_NQ 2
#endif
#ifndef G6_REPS
#define G6_REPS 1
#endif
#ifndef ATT_REPS
#define ATT_REPS 1
#endif
#ifndef PREP_REPS
#define PREP_REPS 1
#endif
constexpr int NPHASE = 10 * DEPTH_ + 1;
static_assert(C_LDS_END <= LDS_BYTES && 8 * 8448 <= LDS_BYTES, "LDS map");
struct Args { const float* in[14]; float* out; unsigned char* ws; int lo, hi; };
__global__ void __launch_bounds__(NWAVES * 64, 2) mega(Args a) {
    extern __shared__ __attribute__((aligned(16))) unsigned char lds_raw[];
    LAS unsigned char* lds = (LAS unsigned char*)lds_raw;
    const int wave = __builtin_amdgcn_readfirstlane((int)threadIdx.x >> 6);
#define OTID() ({ int t_ = threadIdx.x; asm volatile("" : "+v"(t_)); t_; })
#define LANE() (OTID() & 63)
#define GTID() (vcu * NWAVES * 64 + OTID())
    const int G = gridDim.x, bx = blockIdx.x, vcu = (G % 8 == 0) ? (bx % 8) * (G / 8) + bx / 8 : bx;
    const int gw = vcu * NWAVES + wave, ngw = G * NWAVES, ngt = G * NWAVES * 64;
    Ptrs p;
    p.x = a.in[0]; p.pos = (const int*)a.in[1]; p.w_in = a.in[2]; p.sink = a.in[3];  p.w_out = a.in[7];
    p.f1i = a.in[8]; p.f1o = a.in[9]; p.f2i = a.in[10]; p.f2o = a.in[11]; p.lng = a.in[12]; p.lnb = a.in[13];
    unsigned char* ws = a.ws;
    p.Y = a.out; p.stats = (float*)(ws + WS_STATS); p.cosT = (float*)(ws + WS_ROPE); p.sinT = p.cosT + (size_t)T_ * 32; p.ones = (float*)(ws + WS_LNV); p.zeros = p.ones + 1024;
    p.aux = (float*)(ws + WS_AUX); p.LSE = (float*)(ws + WS_LSE); p.Yb = (bf16_t*)(ws + WS_YB); p.Wb = (bf16_t*)(ws + WS_W); p.BIG = (bf16_t*)(ws + WS_BIG); p.OB = (bf16_t*)(ws + WS_OBUF); p.ACX = (bf16_t*)(ws + WS_ACX);
#if !MK_MULTI
    cg::grid_group grid = cg::this_grid();
    if (threadIdx.x < 64) ((LAS unsigned*)(lds + LDS_MISC))[threadIdx.x] = 0u;
    __syncthreads();
    XcdBarrier xbar = xcd_barrier_post((unsigned*)(a.ws + WS_CTL), (volatile LAS unsigned*)(lds + LDS_MISC));
#endif
    const int lo = a.lo, hi = a.hi;
#define IN(k) (lo <= (k) && (k) < hi)
#if MK_MULTI
#define SEAM(k) do { } while (0)
#else
#define SEAM(k) do { if (IN(k) && IN((k) + 1)) { if ((k) == 0) grid.sync(); else xcd_barrier(xbar); } } while (0)
#endif
    for (int l = 0; l < DEPTH_; ++l) {
        const int pb = 10 * l;
        const int s0 = 3 * l;
        const float* gp; const float* bp;
        if (IN(pb + 0)) for (int rep_ = 0; rep_ < PREP_REPS; ++rep_) {
#ifndef NO_PREP
 prep_layer(p, a.in, l, lds, gw, ngw, wave, LANE()); if (l == 0) prologue(p, GTID(), ngt);
#endif
 }
        SEAM(pb + 0);
        if (IN(pb + 1)) {
#ifndef NO_G1
 pg8::Gemm g{p.Yb, p.Wb + WE_1, 64, D_, 1}; pg8::StaticOrder S; S.init(T_, 2 * FF_, G, bx);
            EpiSwiglu E{p.BIG, p.stats + (size_t)((s0 + 1) & 1) * T_ * 32, p.aux + AUX_G1, p.aux + AUX_B1};
            pg8::gemm_phase<EpiSwiglu, pg8::StaticOrder, true, true>(lds, g, S, E);
#endif
        }
        SEAM(pb + 1);
        if (IN(pb + 2)) {
#ifndef NO_G2
 pg8::Gemm g{p.BIG, p.Wb + WE_2, 64, FF_, 1}; pg8::StaticOrder S; S.init(T_, D_, G, bx);
            gp = (l == 0) ? p.ones : p.lng + (size_t)((l - 1) * 3 + 2) * D_; bp = (l == 0) ? p.zeros : p.lnb + (size_t)((l - 1) * 3 + 2) * D_;
            EpiResid E{(l == 0) ? p.x : p.Y, p.Y, p.Yb, p.stats + (size_t)((s0 + 1) & 1) * T_ * 32, p.stats + (size_t)(s0 & 1) * T_ * 32, gp, bp, 0.5f};
            pg8::gemm_phase<EpiResid, pg8::StaticOrder, true, true>(lds, g, S, E);
#endif
        }
        SEAM(pb + 2);
        if (IN(pb + 3)) {
#ifndef NO_G3
 pg8::Gemm g{p.Yb, p.Wb + WE_3, 64, D_, 1}; pg8::StaticOrder S; S.init(T_, NP_, G, bx);
            EpiProj E{p.BIG, p.stats + (size_t)(s0 & 1) * T_ * 32, p.aux + AUX_G3, p.aux + AUX_B3, p.cosT, p.sinT};
            pg8::gemm_phase<EpiProj, pg8::StaticOrder, true, true>(lds, g, S, E);
#endif
        }
        SEAM(pb + 3);
        if (IN(pb + 4)) for (int rep_ = 0; rep_ < ATT_REPS; ++rep_) {
#ifndef NO_DSA
            for (int dr_ = 0; dr_ < DSA_REPS; ++dr_) for (int idx = vcu; idx < NB_ * 128; idx += G) { const int k = idx >> 8, v = idx & 255, b = (v >> 5) + 8 * (k & 1), c32 = v & 31, k2 = k >> 1, blk = 32 * k2 + ((k2 & 1) ? 31 - c32 : c32);
                dsa_unit(b, blk, p.BIG, p.OB, lds, wave, OTID()); }
#endif
#ifndef NO_BAND
            LAS unsigned char* vl = lds + C_VST + wave * 4096;
            for (int br_ = 0; br_ < BAND_REPS; ++br_) for (int u = gw; u < 4 * NB_ * 8 * (SEQ_ / (16 * BAND_NQ)); u += ngw) band_unit<BAND_NQ>(u, p.BIG, p.OB, p.ACX, p.LSE, p.sink + l * 8, vl, LANE());
#endif
        }
        SEAM(pb + 4);
        if (IN(pb + 5)) {
#ifndef NO_G5
 combine_a(p, GTID(), ngt);
            pg8::Gemm g{p.Yb, p.Wb + WE_4, 64, D_, 1}; pg8::StaticOrder S; S.init(T_, NG_, G, bx);
            EpiGate E{p.BIG, p.stats + (size_t)(s0 & 1) * T_ * 32, p.aux + AUX_G4, p.aux + AUX_B4};
            pg8::gemm_phase<EpiGate, pg8::StaticOrder, true, true>(lds, g, S, E);
#endif
        }
        SEAM(pb + 5);
        if (IN(pb + 6)) for (int rep_ = 0; rep_ < G6_REPS; ++rep_) {
#ifndef NO_G6
 pg8::Gemm g{p.OB, p.Wb + WE_5, NO_, NO_, 0}; pg8::StaticOrder S; S.init(T_, D_, G, bx);
            EpiBranch E{p.BIG, p.ACX};
            pg8::gemm_phase<EpiBranch, pg8::StaticOrder, true, true>(lds, g, S, E);
#endif
        }
        SEAM(pb + 6);
        if (IN(pb + 7)) {
#ifndef NO_G7
 pg8::Gemm g{p.ACX, p.Wb + WE_6, 64, D_, 1}; pg8::StaticOrder S; S.init(T_, D_, G, bx);
            EpiResid E{p.Y, p.Y, p.Yb, p.stats + (size_t)(s0 & 1) * T_ * 32, p.stats + (size_t)((s0 + 1) & 1) * T_ * 32, p.lng + (size_t)(l * 3 + 0) * D_, p.lnb + (size_t)(l * 3 + 0) * D_, 1.0f};
            pg8::gemm_phase<EpiResid, pg8::StaticOrder, true, true>(lds, g, S, E);
#endif
        }
        SEAM(pb + 7);
        if (IN(pb + 8)) {
#ifndef NO_G8
 pg8::Gemm g{p.Yb, p.Wb + WE_7, 64, D_, 1}; pg8::StaticOrder S; S.init(T_, 2 * FF_, G, bx);
            EpiSwiglu E{p.BIG, p.stats + (size_t)((s0 + 1) & 1) * T_ * 32, p.aux + AUX_G7, p.aux + AUX_B7};
            pg8::gemm_phase<EpiSwiglu, pg8::StaticOrder, true, true>(lds, g, S, E);
#endif
        }
        SEAM(pb + 8);
        if (IN(pb + 9)) {
#ifndef NO_G9
 pg8::Gemm g{p.BIG, p.Wb + WE_8, 64, FF_, 1}; pg8::StaticOrder S; S.init(T_, D_, G, bx);
            EpiResid E{p.Y, p.Y, p.Yb, p.stats + (size_t)((s0 + 1) & 1) * T_ * 32, p.stats + (size_t)(s0 & 1) * T_ * 32, p.lng + (size_t)(l * 3 + 1) * D_, p.lnb + (size_t)(l * 3 + 1) * D_, 0.5f};
            pg8::gemm_phase<EpiResid, pg8::StaticOrder, true, true>(lds, g, S, E);
#endif
        }
        SEAM(pb + 9);
    }
    if (IN(10 * DEPTH_)) final_ln(p, p.stats + (size_t)T_ * 32, p.lng + (size_t)((DEPTH_ - 1) * 3 + 2) * D_, p.lnb + (size_t)((DEPTH_ - 1) * 3 + 2) * D_, gw, ngw, LANE());
#undef IN
#undef SEAM
}

extern "C" void kernel_launch(void* const* d_in, const int* in_sizes, int n_in, void* d_out, int out_size, void* d_ws, size_t ws_size, hipStream_t stream) {
    static int grid = 0;
    if (grid == 0) {
        if (n_in != 14 || in_sizes[0] != T_ * D_ || out_size != T_ * D_ || ws_size < WS_END) { fprintf(stderr, "kernel_launch: unexpected shapes/workspace (n_in %d, ws %zu, need %zu)\n", n_in, ws_size, (size_t)WS_END); grid = -1; return; }
        int dev = 0, cus = 0, per_cu = 0;
        if (hipGetDevice(&dev) != hipSuccess || hipDeviceGetAttribute(&cus, hipDeviceAttributeMultiprocessorCount, dev) != hipSuccess) { grid = -1; return; }
        if (hipFuncSetAttribute((const void*)mega, hipFuncAttributeMaxDynamicSharedMemorySize, LDS_BYTES) != hipSuccess) { fprintf(stderr, "kernel_launch: hipFuncSetAttribute failed\n"); grid = -1; return; }
        if (hipOccupancyMaxActiveBlocksPerMultiprocessor(&per_cu, (const void*)mega, NWAVES * 64, LDS_BYTES) != hipSuccess || per_cu < 1) { fprintf(stderr, "kernel_launch: occupancy query says %d\n", per_cu); per_cu = 1; }
        (void)hipGetLastError();
        grid = cus * 1;
    }
    if (grid < 0) return;
    Args a{};
    for (int i = 0; i < 14; ++i) a.in[i] = (const float*)d_in[i];
    a.out = (float*)d_out; a.ws = (unsigned char*)d_ws;
#if MK_MULTI
    for (int ph = 0; ph < NPHASE; ++ph) { a.lo = ph; a.hi = ph + 1; hipLaunchKernelGGL(mega, dim3(grid), dim3(NWAVES * 64), LDS_BYTES, stream, a); }
#else
    a.lo = 0; a.hi = NPHASE;
    if (hipMemsetAsync((char*)d_ws + WS_CTL, 0, CTL_BYTES, stream) != hipSuccess) { fprintf(stderr, "kernel_launch: memset failed\n"); return; }
    void* args[] = {&a};
    hipError_t e = hipLaunchCooperativeKernel((const void*)mega, dim3(grid), dim3(NWAVES * 64), args, LDS_BYTES, stream);
    if (e != hipSuccess) fprintf(stderr, "kernel_launch: cooperative launch failed: %s (grid %d)\n", hipGetErrorString(e), grid);
#endif
}
```

```cpp
#define BAND_NQ 4
#include <hip/hip_runtime.h>
#include <hip/hip_cooperative_groups.h>
#include <cstdio>
#include <cstdint>
namespace cg = cooperative_groups;

#ifndef MK_MULTI
#define MK_MULTI 0
#endif

constexpr int T_ = 32768, D_ = 1024, FF_ = 2816, SEQ_ = 2048, NB_ = 16, DEPTH_ = 4;
constexpr int NP_ = 3584, NG_ = 3072, NO_ = 1536, DIN_ = 6600;
constexpr float LN_EPS_ = 1e-5f;
constexpr float ALPHA_ = 1.6817928305074292f;
constexpr float SC2_ = 0.125f * 1.4426950408889634f;
constexpr int PC_QA = 0, PC_KA = 512, PC_QB = 1024, PC_QC = 1536, PC_QI = 2048, PC_KB = 2560, PC_KC = 2688, PC_KI = 2752, PC_VA = 2816, PC_VB = 3328, PC_VC = 3456, PC_WI = 3520;
constexpr int SC_QA = 0, SC_KA = 512, SC_VA = 1024, SC_QB = 1536, SC_KB = 2048, SC_VB = 2176, SC_QC = 2304, SC_KC = 2816, SC_VC = 2880, SC_QI = 2944, SC_KI = 3456, SC_WI = 3520, SC_G = 3528;

constexpr size_t MiB = 1u << 20;
constexpr size_t WS_STATS = 0;
constexpr size_t WS_ROPE  = 8 * MiB;
constexpr size_t WS_LNV   = 16 * MiB;
constexpr size_t WS_AUX   = WS_LNV + 8192;
constexpr int AUX_G1 = 0, AUX_B1 = 5632, AUX_G3 = 11264, AUX_B3 = 14848, AUX_G4 = 18432, AUX_B4 = 21504, AUX_G7 = 24576, AUX_B7 = 30208, AUX_END = 35840;
constexpr size_t WS_LSE   = 17 * MiB;
constexpr size_t WS_YB    = 20 * MiB;
constexpr size_t WS_W     = 84 * MiB;
constexpr size_t WE_1 = 0, WE_2 = WE_1 + (size_t)5632 * 1024, WE_3 = WE_2 + (size_t)1024 * 2816, WE_4 = WE_3 + (size_t)3584 * 1024, WE_5 = WE_4 + (size_t)3072 * 1024,
                 WE_6 = WE_5 + (size_t)3072 * 512, WE_7 = WE_6 + (size_t)1024 * 1024, WE_8 = WE_7 + (size_t)5632 * 1024, WE_END = WE_8 + (size_t)1024 * 2816;
static_assert(WE_END * 2 <= 52 * MiB, "weights");
constexpr size_t WS_BIG   = 136 * MiB;
constexpr size_t WS_OBUF  = 360 * MiB;
constexpr size_t WS_ACX   = 456 * MiB;
constexpr size_t WS_END   = 520 * MiB;
static_assert(WS_AUX + AUX_END * 4 <= WS_LSE && WS_LSE + 3 * MiB <= WS_YB && WS_BIG + (size_t)T_ * NP_ * 2 <= WS_OBUF, "ws map");

#define LAS __attribute__((address_space(3)))
typedef unsigned short bf16_t;
typedef short bf16x8 __attribute__((ext_vector_type(8)));
typedef short s16x4 __attribute__((ext_vector_type(4)));
typedef float f32x4 __attribute__((ext_vector_type(4)));
typedef float f32x2 __attribute__((ext_vector_type(2)));
typedef unsigned u32x4 __attribute__((ext_vector_type(4)));
typedef unsigned u32x2 __attribute__((ext_vector_type(2)));
__device__ __forceinline__ unsigned f2bf(float f) { unsigned u = __float_as_uint(f); return (u + 0x7fffu + ((u >> 16) & 1u)) >> 16; }
__device__ __forceinline__ float bf2f(unsigned v) { return __uint_as_float(v << 16); }
typedef __bf16 bf16x2_t __attribute__((ext_vector_type(2)));
__device__ __forceinline__ unsigned cvt_pk_bf16(float lo, float hi) { const f32x2 v = {lo, hi}; const bf16x2_t b = __builtin_convertvector(v, bf16x2_t); return __builtin_bit_cast(unsigned, b); }
__device__ __forceinline__ float fast_exp2(float x) { return __builtin_amdgcn_exp2f(x); }
__device__ __forceinline__ float fast_rcp(float x) { return __builtin_amdgcn_rcpf(x); }
__device__ __forceinline__ float xmax16(float v) { const auto r = __builtin_amdgcn_permlane16_swap(__float_as_uint(v), __float_as_uint(v), false, false); return fmaxf(__uint_as_float(r[0]), __uint_as_float(r[1])); }
__device__ __forceinline__ float xmax32(float v) { const auto r = __builtin_amdgcn_permlane32_swap(__float_as_uint(v), __float_as_uint(v), false, false); return fmaxf(__uint_as_float(r[0]), __uint_as_float(r[1])); }
__device__ __forceinline__ float xsum16(float v) { const auto r = __builtin_amdgcn_permlane16_swap(__float_as_uint(v), __float_as_uint(v), false, false); return __uint_as_float(r[0]) + __uint_as_float(r[1]); }
__device__ __forceinline__ float xsum32(float v) { const auto r = __builtin_amdgcn_permlane32_swap(__float_as_uint(v), __float_as_uint(v), false, false); return __uint_as_float(r[0]) + __uint_as_float(r[1]); }
__device__ __forceinline__ float sigmoid_f(float x) { return fast_rcp(1.0f + fast_exp2(-1.4426950408889634f * x)); }
__device__ __forceinline__ void row_stats(const float* st, int row, int fq, float& mu, float& rstd) {
    const f32x4* p = (const f32x4*)(st + (size_t)row * 32 + fq * 8);
    const f32x4 a = p[0], b = p[1];
    float s1 = (a[0] + a[2]) + (b[0] + b[2]), s2 = (a[1] + a[3]) + (b[1] + b[3]);
    s1 = xsum32(xsum16(s1)); s2 = xsum32(xsum16(s2));
    mu = s1 * (1.0f / 1024.0f); const float var = fmaxf(s2 * (1.0f / 1024.0f) - mu * mu, 0.f); rstd = rsqrtf(var + LN_EPS_);
}

__device__ __forceinline__ size_t blk_off(int r, int c, int K) { return (size_t)(r >> 8) * 256 * K + (size_t)(c >> 6) * (256 * 64) + (size_t)((r & 255) * 64 + (c & 63)); }

namespace pg8 {
#define PG8_LAS __attribute__((address_space(3)))
constexpr int BM = 256, BK = 64, HALF = 128, HTB = HALF * BK * 2, STAGE_BYTES = 8 * HTB, NXCD = 8, WGM = 8;
__host__ __device__ __forceinline__ int lds_byte(int r, int c) { const int st = (r >> 4) * 2 + (c >> 5), rr = r & 15, cc = c & 31, ob = rr * 64 + cc * 2; return st * 1024 + (ob ^ (((ob >> 9) & 1) << 5)); }
__host__ __device__ __forceinline__ void stage_rc(int b, int& R, int& C) { const int st = b / 1024, sb = b % 1024, swz = sb ^ (((sb >> 9) & 1) << 5); R = (st >> 1) * 16 + swz / 64; C = (st & 1) * 32 + (swz % 64) / 2; }
__host__ __device__ __forceinline__ int perm32(int rho) { const int n = rho >> 4, i = rho & 15; return 8 * (i >> 2) + 4 * n + (i & 3); }
struct Unit { int pm, pn, ac; };
struct Gemm { const bf16_t* A; const bf16_t* Bt; int lda, K, blk; };
struct StaticOrder {
    int nM, nN, nwg, G, c;
    __device__ void init(int M, int N, int G_, int c_) { nM = M / BM; nN = N / BM; nwg = nM * nN; G = G_; c = c_; }
    __device__ bool next(int i, Unit& u) const {
        const long L = (long)i * G + c; if (L >= nwg) return false;
        int wgid = (int)L; { const int q = nwg / NXCD, r = nwg % NXCD, xcd = wgid % NXCD, off = wgid / NXCD; wgid = (xcd < r ? xcd * (q + 1) : r * (q + 1) + (xcd - r) * q) + off; }
        const int nig = WGM * nN, gid = wgid / nig, fm = gid * WGM, gsz = (nM - fm) < WGM ? (nM - fm) : WGM;
        u.pm = fm + ((wgid % nig) % gsz); u.pn = (wgid % nig) / gsz; u.ac = 0; return true;
    }
    __device__ __forceinline__ void a_ready(const Unit&) const {}
    __device__ __forceinline__ void done(const Unit&) const {}
};
struct BranchOrder {
    StaticOrder so;
    __device__ void init(int G_, int c_) { so.init(T_, 1024, G_, c_); }
    __device__ bool next(int i, Unit& u) const { const int br = i % 3; if (!so.next(i / 3, u)) return false; u.pn += 4 * br; u.ac = br * 512 * 2; return true; }
    __device__ __forceinline__ void a_ready(const Unit&) const {}
    __device__ __forceinline__ void done(const Unit&) const {}
};
template <class Epi, class Sched, bool ALIGN_EPI = false, bool SP2 = false>
__device__ __forceinline__ void gemm_phase(PG8_LAS unsigned char* lds, const Gemm g, const Sched& S, const Epi& E) {
    int tid_ = threadIdx.x; asm volatile("" : "+v"(tid_));
    const int tid = tid_, wid = __builtin_amdgcn_readfirstlane(tid >> 6), lane = tid & 63, wr = wid >> 2, wc = wid & 3, fr = lane & 15, fq = lane >> 4;
    const int K = g.K, nt = K / BK, LDA = g.lda;
    unsigned voffA[2], voffB[2];
#pragma unroll
    for (int i = 0; i < 2; ++i) { int R, C; stage_rc(tid * 16 + i * 8192, R, C); const int Rb = Epi::PERM ? ((R & ~31) + perm32(R & 31)) : R;
        voffA[i] = (unsigned)(R * LDA + C) * 2u; voffB[i] = (unsigned)(Rb * K + C) * 2u; }
    const size_t kstepB = (size_t)(BK * 2), kstepA = g.blk ? (size_t)(BM * BK * 2) : kstepB;
    const size_t hstepB = (size_t)HALF * K * 2, hstepA = (size_t)HALF * LDA * 2;
    const size_t tstepA = g.blk ? (size_t)BM * K * 2 : 2 * hstepA, tstepB = 2 * hstepB;
    const unsigned ldsw = (unsigned)wid * 1024u;
    const int aoff = lds_byte(wr * 64 + fr, fq * 8), boff = lds_byte(wc * 32 + fr, fq * 8);
#define PG8_SA(b, h) (((b) * 2 + (h)) * HTB)
#define PG8_SB(b, h) ((4 + (b) * 2 + (h)) * HTB)
#define PG8_STAGE(bufoff, gbase, voff) do { _Pragma("unroll") for (int _i = 0; _i < 2; ++_i) \
        __builtin_amdgcn_global_load_lds((const unsigned*)((const char*)(gbase) + (voff)[_i]), (PG8_LAS unsigned*)(lds + (bufoff) + ldsw + _i * 8192), 16, 0, 0); } while (0)
#define PG8_LDA(dst, b, h) do { _Pragma("unroll") for (int m = 0; m < 4; ++m) _Pragma("unroll") for (int k = 0; k < 2; ++k) dst[m][k] = *(const PG8_LAS bf16x8*)(lds + PG8_SA(b, h) + aoff + m * 2048 + k * 1024); } while (0)
#define PG8_LDB(dst, b, h) do { _Pragma("unroll") for (int n = 0; n < 2; ++n) _Pragma("unroll") for (int k = 0; k < 2; ++k) dst[n][k] = *(const PG8_LAS bf16x8*)(lds + PG8_SB(b, h) + boff + n * 2048 + k * 1024); } while (0)
#define PG8_MMA(ai, bj, At, Bt) do { __builtin_amdgcn_s_setprio(1); _Pragma("unroll") for (int m = 0; m < 4; ++m) _Pragma("unroll") for (int n = 0; n < 2; ++n) _Pragma("unroll") for (int k = 0; k < 2; ++k) \
        acc[ai][bj][m][n] = __builtin_amdgcn_mfma_f32_16x16x32_bf16(Bt[n][k], At[m][k], acc[ai][bj][m][n], 0, 0, 0); __builtin_amdgcn_s_setprio(0); } while (0)
#define PG8_WAIT_V(n) asm volatile("s_waitcnt vmcnt(" #n ")" ::: "memory")
#define PG8_WAIT_L(n) asm volatile("s_waitcnt lgkmcnt(" #n ")" ::: "memory")
#define PG8_BAR __builtin_amdgcn_s_barrier()
#define PG8_SCHED __builtin_amdgcn_sched_barrier(0)
    Unit cur, nxt; int ui = 0;
    if (!S.next(0, cur)) return;
    f32x4 acc[2][2][4][2];
#pragma unroll
    for (int a = 0; a < 2; ++a)
#pragma unroll
        for (int b = 0; b < 2; ++b)
#pragma unroll
            for (int m = 0; m < 4; ++m)
#pragma unroll
                for (int n = 0; n < 2; ++n) acc[a][b][m][n] = (f32x4){0.f, 0.f, 0.f, 0.f};
    bf16x8 At[4][2], B0[2][2], B1[2][2];
    const char* cA = (const char*)g.A + (size_t)cur.pm * tstepA + cur.ac; const char* cB = (const char*)g.Bt + (size_t)cur.pn * tstepB;
    S.a_ready(cur);
    if constexpr (SP2) {
        PG8_STAGE(PG8_SB(0, 0), cB, voffB); PG8_STAGE(PG8_SB(0, 1), cB + hstepB, voffB); PG8_STAGE(PG8_SA(0, 0), cA, voffA); PG8_STAGE(PG8_SA(0, 1), cA + hstepA, voffA);
        if (wr == 1) PG8_BAR;
        PG8_WAIT_V(2); PG8_BAR;
        PG8_STAGE(PG8_SB(1, 0), cB + kstepB, voffB); PG8_STAGE(PG8_SA(1, 0), cA + kstepA, voffA); PG8_STAGE(PG8_SB(1, 1), cB + hstepB + kstepB, voffB);
        PG8_WAIT_V(6); PG8_BAR;
    } else {
        PG8_STAGE(PG8_SB(0, 0), cB, voffB); PG8_STAGE(PG8_SA(0, 0), cA, voffA); PG8_STAGE(PG8_SB(0, 1), cB + hstepB, voffB); PG8_STAGE(PG8_SA(0, 1), cA + hstepA, voffA);
        if (wr == 1) PG8_BAR;
        PG8_WAIT_V(4); PG8_BAR;
        PG8_STAGE(PG8_SB(1, 0), cB + kstepB, voffB); PG8_STAGE(PG8_SA(1, 0), cA + kstepA, voffA); PG8_STAGE(PG8_SB(1, 1), cB + hstepB + kstepB, voffB);
        PG8_WAIT_V(6); PG8_BAR;
    }
    for (;;) {
        const bool has_next = S.next(ui + 1, nxt);
        const char* nA = has_next ? (const char*)g.A + (size_t)nxt.pm * tstepA + nxt.ac : cA; const char* nB = has_next ? (const char*)g.Bt + (size_t)nxt.pn * tstepB : cB;
        for (int t = 0; t < nt; t += 2) {
            if constexpr (Epi::MIDK) { if (t == 8 || t == 16) E.mid(acc, cur, t, wr, wc, fr, fq); }
            const bool last = (t == nt - 2);
            const char* a1 = cA + (size_t)(t + 1) * kstepA;
            const char* a2 = last ? nA : cA + (size_t)(t + 2) * kstepA; const char* b2 = last ? nB : cB + (size_t)(t + 2) * kstepB;
            const char* a3 = a2 + kstepA; const char* b3 = b2 + kstepB;
            if (last && has_next) S.a_ready(nxt);
            if constexpr (SP2) {
            PG8_LDB(B0, 0, 0); PG8_LDB(B1, 0, 1); PG8_SCHED; PG8_LDA(At, 0, 0); PG8_STAGE(PG8_SA(1, 1), a1 + hstepA, voffA);
            PG8_WAIT_V(8); PG8_WAIT_L(0); PG8_BAR; PG8_MMA(0, 0, At, B0); PG8_MMA(0, 1, At, B1); PG8_BAR; PG8_SCHED;
            PG8_LDA(At, 0, 1); PG8_STAGE(PG8_SB(0, 0), b2, voffB); PG8_STAGE(PG8_SB(0, 1), b2 + hstepB, voffB); PG8_STAGE(PG8_SA(0, 0), a2, voffA);
            PG8_WAIT_V(8); PG8_WAIT_L(0); PG8_BAR; PG8_MMA(1, 0, At, B0); PG8_MMA(1, 1, At, B1); PG8_BAR; PG8_SCHED;
            PG8_LDB(B0, 1, 0); PG8_LDB(B1, 1, 1); PG8_SCHED; PG8_LDA(At, 1, 0); PG8_STAGE(PG8_SA(0, 1), a2 + hstepA, voffA);
            PG8_WAIT_V(8); PG8_WAIT_L(0); PG8_BAR; PG8_MMA(0, 0, At, B0); PG8_MMA(0, 1, At, B1); PG8_BAR; PG8_SCHED;
            PG8_LDA(At, 1, 1); PG8_STAGE(PG8_SB(1, 0), b3, voffB); PG8_STAGE(PG8_SB(1, 1), b3 + hstepB, voffB); PG8_STAGE(PG8_SA(1, 0), a3, voffA);
            PG8_WAIT_V(8); PG8_WAIT_L(0); PG8_BAR; PG8_MMA(1, 0, At, B0); PG8_MMA(1, 1, At, B1); PG8_BAR; PG8_SCHED;
            } else {
            PG8_LDB(B0, 0, 0); PG8_SCHED; PG8_LDA(At, 0, 0); PG8_STAGE(PG8_SA(1, 1), a1 + hstepA, voffA);
            PG8_WAIT_L(8); PG8_BAR; PG8_WAIT_L(0); PG8_MMA(0, 0, At, B0); PG8_BAR; PG8_SCHED;
            PG8_LDB(B1, 0, 1); PG8_STAGE(PG8_SB(0, 0), b2, voffB);
            PG8_BAR; PG8_WAIT_L(0); PG8_MMA(0, 1, At, B1); PG8_BAR;
            PG8_LDA(At, 0, 1); PG8_STAGE(PG8_SA(0, 0), a2, voffA);
            PG8_BAR; PG8_WAIT_L(0); PG8_MMA(1, 0, At, B0); PG8_BAR; PG8_SCHED;
            PG8_STAGE(PG8_SB(0, 1), b2 + hstepB, voffB);
            PG8_WAIT_V(6); PG8_BAR; PG8_MMA(1, 1, At, B1); PG8_BAR;
            PG8_LDB(B0, 1, 0); PG8_SCHED; PG8_LDA(At, 1, 0); PG8_STAGE(PG8_SA(0, 1), a2 + hstepA, voffA);
            PG8_WAIT_L(8); PG8_BAR; PG8_WAIT_L(0); PG8_MMA(0, 0, At, B0); PG8_BAR; PG8_SCHED;
            PG8_LDB(B1, 1, 1); PG8_STAGE(PG8_SB(1, 0), b3, voffB);
            PG8_BAR; PG8_WAIT_L(0); PG8_MMA(0, 1, At, B1); PG8_BAR;
            PG8_LDA(At, 1, 1); PG8_STAGE(PG8_SA(1, 0), a3, voffA);
            PG8_BAR; PG8_WAIT_L(0); PG8_MMA(1, 0, At, B0); PG8_BAR; PG8_SCHED;
            PG8_STAGE(PG8_SB(1, 1), b3 + hstepB, voffB);
            PG8_WAIT_V(6); PG8_BAR; PG8_MMA(1, 1, At, B1); PG8_BAR;
            }
        }
        if constexpr (ALIGN_EPI) { if (wr == 0) PG8_BAR; }
        if constexpr (!Epi::AFTER_DRAIN) { E(acc, cur, wr, wc, fr, fq); S.done(cur); }
        if (!has_next) break;
#pragma unroll
        for (int a = 0; a < 2; ++a)
#pragma unroll
            for (int b = 0; b < 2; ++b)
#pragma unroll
                for (int m = 0; m < 4; ++m)
#pragma unroll
                    for (int n = 0; n < 2; ++n) acc[a][b][m][n] = (f32x4){0.f, 0.f, 0.f, 0.f};
        cur = nxt; cA = nA; cB = nB; ++ui;
        if constexpr (ALIGN_EPI) { if (wr == 1) PG8_BAR; }
    }
    PG8_WAIT_V(0);
    if constexpr (!ALIGN_EPI) { if (wr == 0) PG8_BAR; }
    PG8_BAR;
    if constexpr (Epi::AFTER_DRAIN) { E.fused(acc, cur, wr, wc, fr, fq, lds, wid, lane); S.done(cur); }
#undef PG8_SA
#undef PG8_SB
#undef PG8_STAGE
#undef PG8_LDA
#undef PG8_LDB
#undef PG8_MMA
#undef PG8_WAIT_V
#undef PG8_WAIT_L
#undef PG8_BAR
#undef PG8_SCHED
}
}

__device__ __forceinline__ u32x4 pack8(const f32x4 a, const f32x4 b) { u32x4 w; w.x = cvt_pk_bf16(a[0], a[1]); w.y = cvt_pk_bf16(a[2], a[3]); w.z = cvt_pk_bf16(b[0], b[1]); w.w = cvt_pk_bf16(b[2], b[3]); return w; }
__device__ __forceinline__ void unpack8(const u32x4 w, f32x4& a, f32x4& b) {
    a[0] = __uint_as_float(w.x << 16); a[1] = __uint_as_float(w.x & 0xffff0000u); a[2] = __uint_as_float(w.y << 16); a[3] = __uint_as_float(w.y & 0xffff0000u);
    b[0] = __uint_as_float(w.z << 16); b[1] = __uint_as_float(w.z & 0xffff0000u); b[2] = __uint_as_float(w.w << 16); b[3] = __uint_as_float(w.w & 0xffff0000u); }
__device__ __forceinline__ f32x4 silu_mul(const f32x4 g, const f32x4 u) { f32x4 r;
#pragma unroll
    for (int e = 0; e < 4; ++e) r[e] = g[e] * sigmoid_f(g[e]) * u[e];
    return r; }

__device__ __forceinline__ void row_stats4(const float* st, int rowb, int fq, float (&mu)[4], float (&rs)[4]) {
    f32x4 a[4], b[4];
#pragma unroll
    for (int m = 0; m < 4; ++m) { const f32x4* p = (const f32x4*)(st + (size_t)(rowb + m * 16) * 32 + fq * 8); a[m] = p[0]; b[m] = p[1]; }
#pragma unroll
    for (int m = 0; m < 4; ++m) { float s1 = (a[m][0] + a[m][2]) + (b[m][0] + b[m][2]), s2 = (a[m][1] + a[m][3]) + (b[m][1] + b[m][3]);
        s1 = xsum32(xsum16(s1)); s2 = xsum32(xsum16(s2));
        const float mm = s1 * (1.0f / 1024.0f); mu[m] = mm; rs[m] = rsqrtf(fmaxf(s2 * (1.0f / 1024.0f) - mm * mm, 0.f) + LN_EPS_); }
    asm volatile("" ::: "memory");
}
struct EpiSwiglu {
    static constexpr bool PERM = true, AFTER_DRAIN = false, MIDK = false;
    bf16_t* H; const float* st; const float* gW; const float* bW;
    __device__ __forceinline__ void operator()(const f32x4 (&acc)[2][2][4][2], const pg8::Unit& u, int wr, int wc, int fr, int fq) const {
        const int row0 = u.pm * 256 + wr * 64 + fr, cl = wc * 32 + fq * 8, cB0 = u.pn * 256 + cl;
        f32x4 g0[2], g1[2], b0[2], b1[2];
#pragma unroll
        for (int n = 0; n < 2; ++n) { g0[n] = *(const f32x4*)(gW + cB0 + 4 * n); g1[n] = *(const f32x4*)(gW + cB0 + 128 + 4 * n); b0[n] = *(const f32x4*)(bW + cB0 + 4 * n); b1[n] = *(const f32x4*)(bW + cB0 + 128 + 4 * n); }
        float muA[4], rsA[4], muB[4], rsB[4]; row_stats4(st, row0, fq, muA, rsA); row_stats4(st, row0 + 128, fq, muB, rsB);
        u32x4 ow[2][4];
#pragma unroll
        for (int ai = 0; ai < 2; ++ai)
#pragma unroll
            for (int m = 0; m < 4; ++m) { const float mu = ai ? muB[m] : muA[m], rs = ai ? rsB[m] : rsA[m]; f32x4 h[2];
#pragma unroll
                for (int n = 0; n < 2; ++n) { const f32x4 zg = (acc[ai][0][m][n] - g0[n] * mu) * rs + b0[n], zu = (acc[ai][1][m][n] - g1[n] * mu) * rs + b1[n]; h[n] = silu_mul(zg, zu); }
                ow[ai][m] = pack8(h[0], h[1]); }
        asm volatile("" ::: "memory");
#pragma unroll
        for (int ai = 0; ai < 2; ++ai)
#pragma unroll
            for (int m = 0; m < 4; ++m) *(u32x4*)(H + blk_off(row0 + ai * 128 + m * 16, u.pn * 128 + cl, FF_)) = ow[ai][m];
    }
};
struct EpiResid {
    static constexpr bool PERM = true, AFTER_DRAIN = false, MIDK = false;
    const float* Yin; float* Y; bf16_t* Yb; const float* stp; float* stn; const float* g; const float* b; float sc;
    __device__ __forceinline__ void operator()(const f32x4 (&acc)[2][2][4][2], const pg8::Unit& u, int wr, int wc, int fr, int fq) const {
        const int row0 = u.pm * 256 + wr * 64 + fr, col0 = u.pn * 256 + wc * 32 + fq * 8;
#pragma unroll
        for (int ai = 0; ai < 2; ++ai) { float mu4[4], rs4[4]; row_stats4(stp, row0 + ai * 128, fq, mu4, rs4);
#pragma unroll
            for (int m = 0; m < 4; ++m) { const int row = row0 + ai * 128 + m * 16; const float mu = mu4[m], rs = rs4[m];
                f32x4 yv[2][2], gq[2][2], bq_[2][2];
#pragma unroll
                for (int bj = 0; bj < 2; ++bj)
#pragma unroll
                    for (int n = 0; n < 2; ++n) { yv[bj][n] = *(const f32x4*)(Yin + (size_t)row * D_ + col0 + bj * 128 + 4 * n); gq[bj][n] = *(const f32x4*)(g + col0 + bj * 128 + 4 * n); bq_[bj][n] = *(const f32x4*)(b + col0 + bj * 128 + 4 * n); }
                asm volatile("" ::: "memory");
                float s1 = 0.f, s2 = 0.f;
#pragma unroll
                for (int bj = 0; bj < 2; ++bj) { float* yp = Y + (size_t)row * D_ + col0 + bj * 128; f32x4 v[2];
#pragma unroll
                    for (int n = 0; n < 2; ++n) { v[n] = (((yv[bj][n] - mu) * rs) * gq[bj][n] + bq_[bj][n]) * ALPHA_ + acc[ai][bj][m][n] * sc;
                        *(f32x4*)(yp + 4 * n) = v[n]; s1 += (v[n][0] + v[n][1]) + (v[n][2] + v[n][3]); s2 += (v[n][0] * v[n][0] + v[n][1] * v[n][1]) + (v[n][2] * v[n][2] + v[n][3] * v[n][3]); }
                    *(u32x4*)(Yb + blk_off(row, col0 + bj * 128, D_)) = pack8(v[0], v[1]); }
                s1 = xsum32(xsum16(s1)); s2 = xsum32(xsum16(s2));
                if (fq == 0) *(f32x2*)(stn + (size_t)row * 32 + (u.pn * 4 + wc) * 2) = (f32x2){s1, s2}; asm volatile("" ::: "memory"); } }
    }
};
struct EpiProj {
    static constexpr bool PERM = true, AFTER_DRAIN = false, MIDK = false;
    bf16_t* P; const float* st; const float* gW; const float* bW; const float* cosT; const float* sinT;
    __device__ __forceinline__ void operator()(const f32x4 (&acc)[2][2][4][2], const pg8::Unit& u, int wr, int wc, int fr, int fq) const {
        const int row0 = u.pm * 256 + wr * 64 + fr, cl = wc * 32 + fq * 8, cB0 = u.pn * 256 + cl;
        const bool rope = u.pn < 11, qsc = (u.pn < 2) || (u.pn >= 4 && u.pn < 8);
#pragma unroll
        for (int ai = 0; ai < 2; ++ai) { float mu4[4], rs4[4]; row_stats4(st, row0 + ai * 128, fq, mu4, rs4);
#pragma unroll
          for (int mh = 0; mh < 2; ++mh) { f32x4 cv[2][2], sv[2][2];
            if (rope) {
#pragma unroll
                for (int mm = 0; mm < 2; ++mm)
#pragma unroll
                    for (int n = 0; n < 2; ++n) { const size_t ro = (size_t)(row0 + ai * 128 + (2 * mh + mm) * 16) * 32 + fq * 8 + 4 * n; cv[mm][n] = *(const f32x4*)(cosT + ro); sv[mm][n] = *(const f32x4*)(sinT + ro); } }
#pragma unroll
            for (int mm = 0; mm < 2; ++mm) { const int m = 2 * mh + mm; const int row = row0 + ai * 128 + m * 16; const float mu = mu4[m], rs = rs4[m];
                f32x4 g0[2], g1[2], b0[2], b1[2];
#pragma unroll
                for (int n = 0; n < 2; ++n) { g0[n] = *(const f32x4*)(gW + cB0 + 4 * n); g1[n] = *(const f32x4*)(gW + cB0 + 128 + 4 * n); b0[n] = *(const f32x4*)(bW + cB0 + 4 * n); b1[n] = *(const f32x4*)(bW + cB0 + 128 + 4 * n); }
                f32x4 t1[2], t2[2];
#pragma unroll
                for (int n = 0; n < 2; ++n) { t1[n] = (acc[ai][0][m][n] - g0[n] * mu) * rs + b0[n]; t2[n] = (acc[ai][1][m][n] - g1[n] * mu) * rs + b1[n]; }
                bf16_t* pr = P + (size_t)row * NP_ + u.pn * 256;
                if (rope) { f32x4 o1[2], o2[2];
#pragma unroll
                    for (int n = 0; n < 2; ++n) { const f32x4 c = cv[mm][n], s = sv[mm][n];
                        o1[n] = t1[n] * c - t2[n] * s; o2[n] = t2[n] * c + t1[n] * s; }
                    if (qsc) { o1[0] *= SC2_; o1[1] *= SC2_; o2[0] *= SC2_; o2[1] *= SC2_; }
                    *(u32x4*)(pr + wc * 64 + fq * 8) = pack8(o1[0], o1[1]); *(u32x4*)(pr + wc * 64 + 32 + fq * 8) = pack8(o2[0], o2[1]);
                } else { *(u32x4*)(pr + cl) = pack8(t1[0], t1[1]); *(u32x4*)(pr + 128 + cl) = pack8(t2[0], t2[1]); } asm volatile("" ::: "memory"); } } }
    }
};
struct EpiGate {
    static constexpr bool PERM = true, AFTER_DRAIN = false, MIDK = false;
    bf16_t* G; const float* st; const float* gW; const float* bW;
    __device__ __forceinline__ void operator()(const f32x4 (&acc)[2][2][4][2], const pg8::Unit& u, int wr, int wc, int fr, int fq) const {
        const int row0 = u.pm * 256 + wr * 64 + fr, cl = wc * 32 + fq * 8, cB0 = u.pn * 256 + cl;
        f32x4 gg[2][2], bb[2][2];
#pragma unroll
        for (int bj = 0; bj < 2; ++bj)
#pragma unroll
            for (int n = 0; n < 2; ++n) { gg[bj][n] = *(const f32x4*)(gW + cB0 + bj * 128 + 4 * n); bb[bj][n] = *(const f32x4*)(bW + cB0 + bj * 128 + 4 * n); }
        float muA[4], rsA[4], muB[4], rsB[4]; row_stats4(st, row0, fq, muA, rsA); row_stats4(st, row0 + 128, fq, muB, rsB);
#pragma unroll
        for (int ai = 0; ai < 2; ++ai)
#pragma unroll
            for (int m = 0; m < 4; ++m) { const float mu = ai ? muB[m] : muA[m], rs = ai ? rsB[m] : rsA[m];
#pragma unroll
                for (int bj = 0; bj < 2; ++bj) { f32x4 z[2];
#pragma unroll
                    for (int n = 0; n < 2; ++n) { z[n] = (acc[ai][bj][m][n] - gg[bj][n] * mu) * rs + bb[bj][n];
#pragma unroll
                        for (int e = 0; e < 4; ++e) z[n][e] = sigmoid_f(z[n][e]); }
                    *(u32x4*)(G + (size_t)(row0 + ai * 128 + m * 16) * NG_ + cB0 + bj * 128) = pack8(z[0], z[1]); }
                asm volatile("" ::: "memory"); }
    }
};
struct EpiBranch {
    static constexpr bool PERM = true, AFTER_DRAIN = false, MIDK = true;
    const bf16_t* G; bf16_t* Mg;
    __device__ __forceinline__ void mid(f32x4 (&acc)[2][2][4][2], const pg8::Unit& u, int t, int wr, int wc, int fr, int fq) const {
        const int brd = (t >> 3) - 1;
        int fr_ = fr; asm volatile("" : "+v"(fr_));
        const int row0 = u.pm * 256 + wr * 64 + fr_, col0 = u.pn * 256 + wc * 32 + fq * 8;
#pragma unroll
        for (int ai = 0; ai < 2; ++ai)
#pragma unroll
            for (int m = 0; m < 4; ++m) { const bf16_t* gp = G + (size_t)(row0 + ai * 128 + m * 16) * NG_ + brd * 1024 + col0;
#pragma unroll
                for (int bj = 0; bj < 2; ++bj)
#pragma unroll
                    for (int n = 0; n < 2; ++n) { const u32x2 x = *(const u32x2*)(gp + bj * 128 + 4 * n), y = *(const u32x2*)(gp + 1024 + bj * 128 + 4 * n);
                        acc[ai][bj][m][n][0] *= __uint_as_float(x.x << 16) * fast_rcp(fmaxf(__uint_as_float(y.x << 16), 1e-30f)); acc[ai][bj][m][n][1] *= __uint_as_float(x.x & 0xffff0000u) * fast_rcp(fmaxf(__uint_as_float(y.x & 0xffff0000u), 1e-30f));
                        acc[ai][bj][m][n][2] *= __uint_as_float(x.y << 16) * fast_rcp(fmaxf(__uint_as_float(y.y << 16), 1e-30f)); acc[ai][bj][m][n][3] *= __uint_as_float(x.y & 0xffff0000u) * fast_rcp(fmaxf(__uint_as_float(y.y & 0xffff0000u), 1e-30f));
                        asm volatile("" ::: "memory"); } }
    }
    __device__ __forceinline__ void operator()(const f32x4 (&acc)[2][2][4][2], const pg8::Unit& u, int wr, int wc, int fr, int fq) const {
        const int row0 = u.pm * 256 + wr * 64 + fr, col0 = u.pn * 256 + wc * 32 + fq * 8;
        u32x4 gw[2][4][2];
#pragma unroll
        for (int ai = 0; ai < 2; ++ai)
#pragma unroll
            for (int m = 0; m < 4; ++m)
#pragma unroll
                for (int bj = 0; bj < 2; ++bj) gw[ai][m][bj] = *(const u32x4*)(G + (size_t)(row0 + ai * 128 + m * 16) * NG_ + 2048 + col0 + bj * 128);
        asm volatile("" ::: "memory");
#pragma unroll
        for (int ai = 0; ai < 2; ++ai)
#pragma unroll
            for (int m = 0; m < 4; ++m)
#pragma unroll
                for (int bj = 0; bj < 2; ++bj) { f32x4 ga, gb; unpack8(gw[ai][m][bj], ga, gb);
                    *(u32x4*)(Mg + blk_off(row0 + ai * 128 + m * 16, col0 + bj * 128, D_)) = pack8(ga * acc[ai][bj][m][0], gb * acc[ai][bj][m][1]); }
    }
};

#ifndef DSA1_REPS
#define DSA1_REPS 1
#endif
#ifndef DSA3_REPS
#define DSA3_REPS 1
#endif
#define MFMA16(a, b, c) __builtin_amdgcn_mfma_f32_16x16x32_bf16((a), (b), (c), 0, 0, 0)
typedef short v4i16_t __attribute__((ext_vector_type(4)));
__device__ __forceinline__ s16x4 tr_read(LAS unsigned char* p) { return __builtin_bit_cast(s16x4, __builtin_amdgcn_ds_read_tr16_b64_v4i16((LAS v4i16_t*)p)); }
struct KVRegs { bf16x8 ka[2], kb[2]; u32x4 v[4]; };
__device__ __forceinline__ void kv_load(KVRegs& r, const bf16_t* kbase, size_t kst, const bf16_t* vbase, int s, int lane) {
    const int li = lane & 15, g4 = lane >> 4;
    const bf16_t* k0 = kbase + (size_t)(32 * s + li) * kst + 8 * g4;
    r.ka[0] = *(const bf16x8*)k0; r.ka[1] = *(const bf16x8*)(k0 + 32);
    const bf16_t* k1 = k0 + 16 * kst;
    r.kb[0] = *(const bf16x8*)k1; r.kb[1] = *(const bf16x8*)(k1 + 32);
    const bf16_t* vp = vbase + (size_t)(32 * s + (lane >> 1)) * kst + (lane & 1) * 32;
#pragma unroll
    for (int i = 0; i < 4; ++i) r.v[i] = *(const u32x4*)(vp + 8 * i);
}
struct BandMask { int k0, iq, W; __device__ __forceinline__ float operator()(int ko, float s) const { return ((unsigned)(iq - (k0 + ko)) <= (unsigned)W) ? s : -INFINITY; } };
struct SelMask { unsigned w; __device__ __forceinline__ float operator()(int ko, float s) const { const int mk = (int)(w << (31 - ko)) >> 31; return __uint_as_float((__float_as_uint(s) & (unsigned)mk) | (0xff800000u & ~(unsigned)mk)); } };
template <class MaskF>
__device__ __forceinline__ void attn_step(const KVRegs& r, const bf16x8 (&bq)[2], LAS unsigned char* vl, int lane, const MaskF mask, float& m, float& l, f32x4 (&o)[4]) {
    const int g4 = lane >> 4;
    { LAS unsigned char* wp = vl + (lane >> 1) * 128 + (lane & 1) * 64;
#pragma unroll
      for (int i = 0; i < 4; ++i) *(LAS u32x4*)(wp + 16 * i) = r.v[i]; }
    f32x4 sa = (f32x4){0.f, 0.f, 0.f, 0.f}, sb = (f32x4){0.f, 0.f, 0.f, 0.f};
    sa = MFMA16(r.ka[0], bq[0], sa); sa = MFMA16(r.ka[1], bq[1], sa);
    sb = MFMA16(r.kb[0], bq[0], sb); sb = MFMA16(r.kb[1], bq[1], sb);
    float x[8];
#pragma unroll
    for (int e = 0; e < 4; ++e) { x[e] = mask(4 * g4 + e, sa[e]); x[4 + e] = mask(16 + 4 * g4 + e, sb[e]); }
    float tm = fmaxf(fmaxf(fmaxf(x[0], x[1]), fmaxf(x[2], x[3])), fmaxf(fmaxf(x[4], x[5]), fmaxf(x[6], x[7])));
    tm = xmax32(xmax16(tm));
    const float mn = fmaxf(m, tm);
    if (__ballot(mn > m)) { const float al = fast_exp2(m - mn); l *= al;
#pragma unroll
        for (int db = 0; db < 4; ++db) o[db] = o[db] * al; }
    m = mn;
    float p[8], ps = 0.f;
#pragma unroll
    for (int e = 0; e < 8; ++e) { p[e] = fast_exp2(x[e] - mn); ps += p[e]; }
    l += ps;
    u32x4 pw; pw.x = cvt_pk_bf16(p[0], p[1]); pw.y = cvt_pk_bf16(p[2], p[3]); pw.z = cvt_pk_bf16(p[4], p[5]); pw.w = cvt_pk_bf16(p[6], p[7]);
    const bf16x8 pf = __builtin_bit_cast(bf16x8, pw);
    asm volatile("s_waitcnt lgkmcnt(0)" ::: "memory");
    LAS unsigned char* rd = vl + (4 * g4 + ((lane & 15) >> 2)) * 128 + (lane & 3) * 8;
#pragma unroll
    for (int db = 0; db < 4; ++db) { const s16x4 t0 = tr_read(rd + db * 32), t1 = tr_read(rd + 16 * 128 + db * 32);
        const bf16x8 vf = (bf16x8){t0[0], t0[1], t0[2], t0[3], t1[0], t1[1], t1[2], t1[3]};
        o[db] = MFMA16(vf, pf, o[db]); }
    asm volatile("s_waitcnt lgkmcnt(0)" ::: "memory");
}
__device__ __forceinline__ void attn_store(const f32x4 (&o)[4], float inv, bf16_t* op, int g4) {
#pragma unroll
    for (int db = 0; db < 4; ++db) { u32x2 w; w.x = cvt_pk_bf16(o[db][0] * inv, o[db][1] * inv); w.y = cvt_pk_bf16(o[db][2] * inv, o[db][3] * inv); *(u32x2*)(op + 16 * db + 4 * g4) = w; }
}
struct BandGen { int iq, W; __device__ __forceinline__ BandMask operator()(int s) const { return BandMask{32 * s, iq, W}; } };
struct SelGen { const LAS unsigned char* row; __device__ __forceinline__ SelMask operator()(int s) const { return SelMask{*(const LAS unsigned*)(row + 4 * s)}; } };
template <class Gen>
__device__ __forceinline__ void attn_loop(const bf16_t* kbase, size_t kst, const bf16_t* vbase, int s_lo, int s_hi, const bf16x8 (&bq)[2], LAS unsigned char* vl, int lane, const Gen gen, float& m, float& l, f32x4 (&o)[4]) {
    KVRegs kv[4];
    kv_load(kv[0], kbase, kst, vbase, s_lo, lane);
    if (s_lo + 1 <= s_hi) kv_load(kv[1], kbase, kst, vbase, s_lo + 1, lane);
    if (s_lo + 2 <= s_hi) kv_load(kv[2], kbase, kst, vbase, s_lo + 2, lane);
    for (int s = s_lo; s <= s_hi; s += 4) {
#pragma unroll
        for (int j = 0; j < 4; ++j) {
            if (s + j <= s_hi) {
                if (s + j + 3 <= s_hi) kv_load(kv[(j + 3) & 3], kbase, kst, vbase, s + j + 3, lane);
                attn_step(kv[j], bq, vl, lane, gen(s + j), m, l, o);
            }
        }
    }
}
template <int NQ>
__device__ __forceinline__ void band_step(const KVRegs& r, const bf16x8 (&bq)[NQ][2], LAS unsigned char* vl, int lane, int s, int q0, int W, float (&m)[NQ], float (&l)[NQ], f32x4 (&o)[NQ][4]) {
    const int g4 = lane >> 4, qi = lane & 15;
    { LAS unsigned char* wp = vl + (lane >> 1) * 128 + (lane & 1) * 64;
#pragma unroll
      for (int i = 0; i < 4; ++i) *(LAS u32x4*)(wp + 16 * i) = r.v[i]; }
    asm volatile("s_waitcnt lgkmcnt(0)" ::: "memory");
    bf16x8 vf[4];
    { LAS unsigned char* rd = vl + (4 * g4 + (qi >> 2)) * 128 + (lane & 3) * 8;
#pragma unroll
      for (int db = 0; db < 4; ++db) { const s16x4 t0 = tr_read(rd + db * 32), t1 = tr_read(rd + 16 * 128 + db * 32);
          vf[db] = (bf16x8){t0[0], t0[1], t0[2], t0[3], t1[0], t1[1], t1[2], t1[3]}; } }
#pragma unroll
    for (int g = 0; g < NQ; ++g) {
        const int qlo = q0 + 16 * g;
        if (32 * s <= qlo + 15 && 32 * s + 31 >= qlo - W) {
            f32x4 sa = (f32x4){0.f, 0.f, 0.f, 0.f}, sb = (f32x4){0.f, 0.f, 0.f, 0.f};
            sa = MFMA16(r.ka[0], bq[g][0], sa); sa = MFMA16(r.ka[1], bq[g][1], sa);
            sb = MFMA16(r.kb[0], bq[g][0], sb); sb = MFMA16(r.kb[1], bq[g][1], sb);
            const BandMask mask{32 * s, qlo + qi, W};
            float x[8];
#pragma unroll
            for (int e = 0; e < 4; ++e) { x[e] = mask(4 * g4 + e, sa[e]); x[4 + e] = mask(16 + 4 * g4 + e, sb[e]); }
            float tm = fmaxf(fmaxf(fmaxf(x[0], x[1]), fmaxf(x[2], x[3])), fmaxf(fmaxf(x[4], x[5]), fmaxf(x[6], x[7])));
            tm = xmax32(xmax16(tm));
            const float mn = fmaxf(m[g], tm);
            if (__ballot(mn > m[g])) { const float al = fast_exp2(m[g] - mn); l[g] *= al;
#pragma unroll
                for (int db = 0; db < 4; ++db) o[g][db] = o[g][db] * al; }
            m[g] = mn;
            float pp[8], ps = 0.f;
#pragma unroll
            for (int e = 0; e < 8; ++e) { pp[e] = fast_exp2(x[e] - mn); ps += pp[e]; }
            l[g] += ps;
            u32x4 pw; pw.x = cvt_pk_bf16(pp[0], pp[1]); pw.y = cvt_pk_bf16(pp[2], pp[3]); pw.z = cvt_pk_bf16(pp[4], pp[5]); pw.w = cvt_pk_bf16(pp[6], pp[7]);
            const bf16x8 pf = __builtin_bit_cast(bf16x8, pw);
#pragma unroll
            for (int db = 0; db < 4; ++db) o[g][db] = MFMA16(vf[db], pf, o[g][db]);
        }
    }
}
template <int NQ>
__device__ __forceinline__ void band_unit(int u, const bf16_t* P, bf16_t* OB, bf16_t* ACX, float* LSE, const float* sink, LAS unsigned char* vl, int lane_in) {
    int lane = lane_in; asm volatile("" : "+v"(lane));
    constexpr int UQ = 16 * NQ, TPS = SEQ_ / UQ, UPC = NB_ * 8 * TPS;
    const int cfg = u / UPC, rr = u % UPC, b = rr / (8 * TPS), h = (rr / TPS) & 7, ts = rr % TPS;
    const int d = (cfg == 1) ? 4 : (cfg == 2) ? 16 : 1, tpc = TPS / d, cls = ts / tpc, it = ts % tpc, q0 = UQ * it, W = (cfg == 3) ? 127 : 128;
    const int qcol = (cfg < 3) ? PC_QA + h * 64 : PC_QB + h * 64, kcol = (cfg < 3) ? PC_KA + h * 64 : PC_KB + (h >> 2) * 64, vcol = (cfg < 3) ? PC_VA + h * 64 : PC_VB + (h >> 2) * 64;
    const size_t rowbase = (size_t)b * SEQ_ + cls, kst = (size_t)d * NP_;
    const bf16_t* kbase = P + rowbase * NP_ + kcol; const bf16_t* vbase = P + rowbase * NP_ + vcol;
    const int qi = lane & 15, g4 = lane >> 4;
    bf16x8 bq[NQ][2]; float m[NQ], l[NQ]; f32x4 o[NQ][4];
#pragma unroll
    for (int g = 0; g < NQ; ++g) { const bf16_t* qp = P + (rowbase + (size_t)d * (q0 + 16 * g + qi)) * NP_ + qcol + 8 * g4; bq[g][0] = *(const bf16x8*)qp; bq[g][1] = *(const bf16x8*)(qp + 32);
        m[g] = -1e30f; l[g] = 0.f; if (cfg == 3) { m[g] = sink[h] * 1.4426950408889634f; l[g] = (g4 == 0) ? 1.f : 0.f; }
#pragma unroll
        for (int db = 0; db < 4; ++db) o[g][db] = (f32x4){0.f, 0.f, 0.f, 0.f}; }
    const int s_hi = (q0 + UQ - 1) >> 5, s_lo = (q0 >= 128) ? ((q0 - 128) >> 5) : 0;
    constexpr int RING = (NQ > 2) ? 2 : 3;
    KVRegs kv[RING];
    kv_load(kv[0], kbase, kst, vbase, s_lo, lane);
    if (RING > 2 && s_lo + 1 <= s_hi) kv_load(kv[1], kbase, kst, vbase, s_lo + 1, lane);
    for (int s = s_lo; s <= s_hi; s += RING) {
#pragma unroll
        for (int j = 0; j < RING; ++j) {
            if (s + j <= s_hi) {
                if (s + j + RING - 1 <= s_hi) kv_load(kv[(j + RING - 1) % RING], kbase, kst, vbase, s + j + RING - 1, lane);
                band_step<NQ>(kv[j], bq, vl, lane, s + j, q0, W, m, l, o);
            }
        }
    }
#pragma unroll
    for (int g = 0; g < NQ; ++g) {
        const size_t tq = rowbase + (size_t)d * (q0 + 16 * g + qi);
        float lt = l[g]; lt = xsum32(xsum16(lt));
        bf16_t* op = (cfg == 0) ? OB + tq * NO_ + h * 64 : (cfg == 3) ? OB + tq * NO_ + 512 + h * 64 : ACX + (size_t)(cfg - 1) * T_ * 512 + tq * 512 + h * 64;
        attn_store(o[g], fast_rcp(lt), op, g4);
        if (cfg < 3 && g4 == 0) LSE[(size_t)cfg * T_ * 8 + tq * 8 + h] = m[g] + __log2f(lt);
    }
}
template <class MaskF>
__device__ __forceinline__ void attn_step_lds(const LAS unsigned char* kl, LAS unsigned char* vl, const bf16x8 (&bq)[2], int lane, const MaskF mask, float& m, float& l, f32x4 (&o)[4]) {
    const int g4 = lane >> 4, li = lane & 15;
    const LAS unsigned char* kp = kl + li * 144 + 16 * g4;
    const bf16x8 ka0 = *(const LAS bf16x8*)kp, ka1 = *(const LAS bf16x8*)(kp + 64), kb0 = *(const LAS bf16x8*)(kp + 16 * 144), kb1 = *(const LAS bf16x8*)(kp + 16 * 144 + 64);
    f32x4 sa = (f32x4){0.f, 0.f, 0.f, 0.f}, sb = (f32x4){0.f, 0.f, 0.f, 0.f};
    sa = MFMA16(ka0, bq[0], sa); sa = MFMA16(ka1, bq[1], sa);
    sb = MFMA16(kb0, bq[0], sb); sb = MFMA16(kb1, bq[1], sb);
    LAS unsigned char* rd = vl + (4 * g4 + (li >> 2)) * 128 + (lane & 3) * 8;
    s16x4 t0[4], t1[4];
#pragma unroll
    for (int db = 0; db < 4; ++db) { t0[db] = tr_read(rd + db * 32); t1[db] = tr_read(rd + 16 * 128 + db * 32); }
    float x[8];
#pragma unroll
    for (int e = 0; e < 4; ++e) { x[e] = mask(4 * g4 + e, sa[e]); x[4 + e] = mask(16 + 4 * g4 + e, sb[e]); }
    float tm = fmaxf(fmaxf(fmaxf(x[0], x[1]), fmaxf(x[2], x[3])), fmaxf(fmaxf(x[4], x[5]), fmaxf(x[6], x[7])));
    tm = xmax32(xmax16(tm));
    const float mn = fmaxf(m, tm);
    if (__ballot(mn > m)) { const float al = fast_exp2(m - mn); l *= al;
#pragma unroll
        for (int db = 0; db < 4; ++db) o[db] = o[db] * al; }
    m = mn;
    float p[8], ps = 0.f;
#pragma unroll
    for (int e = 0; e < 8; ++e) { p[e] = fast_exp2(x[e] - mn); ps += p[e]; }
    l += ps;
    u32x4 pw; pw.x = cvt_pk_bf16(p[0], p[1]); pw.y = cvt_pk_bf16(p[2], p[3]); pw.z = cvt_pk_bf16(p[4], p[5]); pw.w = cvt_pk_bf16(p[6], p[7]);
    const bf16x8 pf = __builtin_bit_cast(bf16x8, pw);
#pragma unroll
    for (int db = 0; db < 4; ++db) { const bf16x8 vf = (bf16x8){t0[db][0], t0[db][1], t0[db][2], t0[db][3], t1[db][0], t1[db][1], t1[db][2], t1[db][3]};
        o[db] = MFMA16(vf, pf, o[db]); }
}
constexpr int C_SCW = 4112, C_IDX = 16 * C_SCW, C_CNT = C_IDX + 16 * 512, C_VT = C_CNT + 64, C_VST = 0, C_LDS_END = C_VT + 8 * 4096;
__device__ __forceinline__ unsigned f16key(unsigned h) { return (h & 0x8000u) ? (~h & 0xffffu) : (h | 0x8000u); }
__device__ __forceinline__ unsigned wave_sum_u32(unsigned c) {
    c += (unsigned)__builtin_amdgcn_update_dpp(0, (int)c, 0x128, 0xf, 0xf, false);
    c += (unsigned)__builtin_amdgcn_update_dpp(0, (int)c, 0x124, 0xf, 0xf, false);
    c += (unsigned)__builtin_amdgcn_update_dpp(0, (int)c, 0x122, 0xf, 0xf, false);
    c += (unsigned)__builtin_amdgcn_update_dpp(0, (int)c, 0x121, 0xf, 0xf, false);
    { const auto r = __builtin_amdgcn_permlane16_swap(c, c, false, false); c = r[0] + r[1]; }
    { const auto r = __builtin_amdgcn_permlane32_swap(c, c, false, false); c = r[0] + r[1]; }
    return c;
}
template <int NJ>
__device__ __forceinline__ void dsa_select(LAS unsigned char* lds, int qs, int t, int lane) {
    unsigned v[NJ];
#pragma unroll
    for (int j = 0; j < NJ; ++j) { const int key = 64 * j + lane; const unsigned raw = *(const LAS unsigned short*)(lds + qs * C_SCW + key * 2); v[j] = (key <= t) ? f16key(raw) : 0u; }
    unsigned theta = 1u; int need = t + 1;
    if (t + 1 > 256) {
        need = 256; theta = 0u;
        for (int bit = 15; bit >= 0; --bit) { const unsigned tr = theta | (1u << bit); unsigned c = 0u;
#pragma unroll
            for (int j = 0; j < NJ; ++j) c += (v[j] >= tr) ? 1u : 0u;
            c = wave_sum_u32(c);
            theta = (c >= 256u) ? tr : theta; }
        theta = (unsigned)__builtin_amdgcn_readfirstlane((int)theta);
    }
    int cgt = 0;
#pragma unroll
    for (int j = 0; j < NJ; ++j) cgt += __popcll(__ballot(v[j] > theta));
    const int rem = need - cgt; int taken = 0, base = 0;
    LAS unsigned short* il = (LAS unsigned short*)(lds + C_IDX + qs * 512);
#pragma unroll
    for (int j = 0; j < NJ; ++j) {
        const bool eq = (v[j] == theta);
        const unsigned long long tmask = __ballot(eq);
        const int rank = (int)__builtin_amdgcn_mbcnt_hi((unsigned)(tmask >> 32), __builtin_amdgcn_mbcnt_lo((unsigned)tmask, 0u)) + taken;
        const bool sel = (v[j] > theta) || (eq && rank < rem);
        const unsigned long long smask = __ballot(sel);
        taken += __popcll(tmask);
        const int pos = base + (int)__builtin_amdgcn_mbcnt_hi((unsigned)(smask >> 32), __builtin_amdgcn_mbcnt_lo((unsigned)smask, 0u));
        if (sel) il[pos] = (unsigned short)(64 * j + lane);
        base += __popcll(smask);
    }
#pragma unroll
    for (int i = 0; i < 4; ++i) { const int pos = base + lane + 64 * i; if (pos < 256) il[pos] = 0; }
    if (lane == 0) *(LAS int*)(lds + C_CNT + qs * 4) = base;
}
struct CountMask { int s32, cnt; __device__ __forceinline__ float operator()(int ko, float s) const { return (s32 + ko < cnt) ? s : -INFINITY; } };
__device__ __forceinline__ void kv_gather(KVRegs& r, const bf16_t* Pb, const LAS unsigned short* il, int s, int lane) {
    const int li = lane & 15, g4 = lane >> 4;
    const unsigned ra = il[32 * s + li], rb = il[32 * s + 16 + li], rv = il[32 * s + (lane >> 1)];
    const bf16_t* k0 = Pb + (size_t)ra * NP_ + PC_KC + 8 * g4; const bf16_t* k1 = Pb + (size_t)rb * NP_ + PC_KC + 8 * g4;
    r.ka[0] = *(const bf16x8*)k0; r.ka[1] = *(const bf16x8*)(k0 + 32); r.kb[0] = *(const bf16x8*)k1; r.kb[1] = *(const bf16x8*)(k1 + 32);
    const bf16_t* vp = Pb + (size_t)rv * NP_ + PC_VC + (lane & 1) * 32;
#pragma unroll
    for (int i = 0; i < 4; ++i) r.v[i] = *(const u32x4*)(vp + 8 * i);
}
__device__ __forceinline__ void dsa_unit(int b, int blk, const bf16_t* P, bf16_t* OB, LAS unsigned char* lds, int wave, int tid_in) {
    int tid = tid_in; asm volatile("" : "+v"(tid));
    const int lane = tid & 63;
    const int t0 = blk * 16, nk = t0 + 16; const size_t tok0 = (size_t)b * SEQ_;
    const int qi = lane & 15, g4 = lane >> 4;
    const bf16_t* qrow = P + (tok0 + t0 + qi) * NP_;
    {
        bf16x8 bqi[8][2]; float w[8];
#pragma unroll
        for (int h = 0; h < 8; ++h) { bqi[h][0] = *(const bf16x8*)(qrow + PC_QI + h * 64 + 8 * g4); bqi[h][1] = *(const bf16x8*)(qrow + PC_QI + h * 64 + 32 + 8 * g4); }
        { const u32x4 ww = *(const u32x4*)(qrow + PC_WI); f32x4 wa, wb; unpack8(ww, wa, wb);
#pragma unroll
          for (int e = 0; e < 4; ++e) { w[e] = wa[e]; w[4 + e] = wb[e]; } }
        const int ntile = nk >> 4;
        const bf16_t* kp0 = P + (tok0 + qi) * NP_ + PC_KI + 8 * g4;
        bf16x8 kf[6][2];
#pragma unroll
        for (int i = 0; i < 5; ++i) if (wave + 8 * i < ntile) { const bf16_t* kp = kp0 + (size_t)(16 * (wave + 8 * i)) * NP_; kf[i][0] = *(const bf16x8*)kp; kf[i][1] = *(const bf16x8*)(kp + 32); }
        for (int kt = wave; kt < ntile; kt += 48) {
#pragma unroll
            for (int j = 0; j < 6; ++j) {
                const int kc = kt + 8 * j;
                if (kc < ntile) {
                    if (kc + 40 < ntile) { const bf16_t* kp = kp0 + (size_t)(16 * (kc + 40)) * NP_; kf[(j + 5) % 6][0] = *(const bf16x8*)kp; kf[(j + 5) % 6][1] = *(const bf16x8*)(kp + 32); }
                    f32x4 sc = (f32x4){0.f, 0.f, 0.f, 0.f};
#pragma unroll
                    for (int h = 0; h < 8; ++h) { f32x4 s = (f32x4){0.f, 0.f, 0.f, 0.f}; s = MFMA16(kf[j][0], bqi[h][0], s); s = MFMA16(kf[j][1], bqi[h][1], s);
#pragma unroll
                        for (int e = 0; e < 4; ++e) sc[e] = fmaf(w[h], fmaxf(s[e], 0.f), sc[e]); }
                    u32x2 o2;
                    { const _Float16 h0 = (_Float16)sc[0], h1 = (_Float16)sc[1], h2 = (_Float16)sc[2], h3 = (_Float16)sc[3];
                      o2.x = (unsigned)__builtin_bit_cast(unsigned short, h0) | ((unsigned)__builtin_bit_cast(unsigned short, h1) << 16);
                      o2.y = (unsigned)__builtin_bit_cast(unsigned short, h2) | ((unsigned)__builtin_bit_cast(unsigned short, h3) << 16); }
                    *(LAS u32x2*)(lds + qi * C_SCW + (16 * kc + 4 * g4) * 2) = o2;
                }
            }
        }
    }
    __syncthreads();
    {
        const int nj = (nk + 63) >> 6;
        for (int qq = 0; qq < 2; ++qq) {
            const int qs = wave * 2 + qq, t = t0 + qs;
            if (nj <= 8) dsa_select<8>(lds, qs, t, lane); else if (nj <= 16) dsa_select<16>(lds, qs, t, lane); else if (nj <= 24) dsa_select<24>(lds, qs, t, lane); else dsa_select<32>(lds, qs, t, lane);
        }
    }
    __syncthreads();
    {
        const bf16_t* Pb = P + tok0 * NP_;
        LAS unsigned char* vl = lds + C_VT + wave * 4096;
        const int col = lane & 15;
        for (int qq = 0; qq < 2; ++qq) {
            const int qs = wave * 2 + qq;
            const LAS unsigned short* il = (const LAS unsigned short*)(lds + C_IDX + qs * 512);
            const int cnt = *(const LAS int*)(lds + C_CNT + qs * 4);
            bf16x8 bq[2];
            { const bf16_t* qp = P + (tok0 + t0 + qs) * NP_ + PC_QC + (col & 7) * 64 + 8 * g4; bq[0] = *(const bf16x8*)qp; bq[1] = *(const bf16x8*)(qp + 32);
              if (col >= 8) { bq[0] = (bf16x8){0, 0, 0, 0, 0, 0, 0, 0}; bq[1] = bq[0]; } }
            float m = -1e30f, l = 0.f; f32x4 o[4];
#pragma unroll
            for (int db = 0; db < 4; ++db) o[db] = (f32x4){0.f, 0.f, 0.f, 0.f};
            const int s_hi = ((cnt + 31) >> 5) - 1;
            KVRegs kv[2];
            kv_gather(kv[0], Pb, il, 0, lane);
            for (int s = 0; s <= s_hi; s += 2) {
#pragma unroll
                for (int j = 0; j < 2; ++j) {
                    if (s + j <= s_hi) {
                        if (s + j + 1 <= s_hi) kv_gather(kv[(j + 1) % 2], Pb, il, s + j + 1, lane);
                        attn_step(kv[j], bq, vl, lane, CountMask{32 * (s + j), cnt}, m, l, o);
                    }
                }
            }
            float lt = l; lt = xsum32(xsum16(lt));
            if (col < 8) attn_store(o, fast_rcp(lt), OB + (tok0 + t0 + qs) * NO_ + 1024 + col * 64, g4);
        }
    }
    __syncthreads();
}

__device__ __forceinline__ void prep_load(f32x4 (&r)[8], const float* W, int N_src, int k0, int src_col, bool cv, int lane) {
    const float* p = W + (size_t)(k0 + (lane >> 3)) * N_src + src_col + 4 * (lane & 7);
#pragma unroll
    for (int i = 0; i < 8; ++i) r[i] = cv ? *(const f32x4*)(p + (size_t)(8 * i) * N_src) : (f32x4){0.f, 0.f, 0.f, 0.f};
}
__device__ __forceinline__ void prep_chunk(const f32x4 (&r)[8], int k0, int ldd, const float* g, const float* b, bf16_t* dst, LAS float* scr, int lane, f32x4& sg, f32x4& sb) {
    const int c4 = lane & 7, r8 = lane >> 3;
#pragma unroll
    for (int i = 0; i < 8; ++i) { const int row = r8 + 8 * i; const float gv = g ? g[k0 + row] : 1.f, bv = b ? b[k0 + row] : 0.f; f32x4 wr;
#pragma unroll
        for (int e = 0; e < 4; ++e) { wr[e] = bf2f(f2bf(r[i][e] * gv)); scr[row * 33 + 4 * c4 + e] = wr[e]; }
        sg += wr; sb += r[i] * bv; }
    asm volatile("s_waitcnt lgkmcnt(0)" ::: "memory");
    const int c = lane & 7;
#pragma unroll
    for (int j = 0; j < 4; ++j) { const int nn = (lane >> 3) + 8 * j; const LAS float* s = scr + (8 * c) * 33 + nn;
        u32x4 o; o.x = (f2bf(s[0]) | (f2bf(s[33]) << 16)); o.y = (f2bf(s[66]) | (f2bf(s[99]) << 16)); o.z = (f2bf(s[132]) | (f2bf(s[165]) << 16)); o.w = (f2bf(s[198]) | (f2bf(s[231]) << 16));
        *(u32x4*)(dst + (size_t)nn * ldd + k0 + 8 * c) = o; }
    asm volatile("s_waitcnt lgkmcnt(0)" ::: "memory");
}
__device__ __forceinline__ void prep_item(const float* W, int N_src, int ldd, int kbeg, int kend, int src_col, int nvalid, const float* g, const float* b, bf16_t* dst, float* gWo, float* bWo, LAS float* scr, int lane_in) {
    int lane = lane_in; asm volatile("" : "+v"(lane));
    const bool cv = 4 * (lane & 7) < nvalid;
    f32x4 sg = (f32x4){0.f, 0.f, 0.f, 0.f}, sb = (f32x4){0.f, 0.f, 0.f, 0.f};
    f32x4 ra[8], rb[8];
    prep_load(ra, W, N_src, kbeg, src_col, cv, lane);
    for (int k0 = kbeg; k0 < kend; k0 += 128) {
        if (k0 + 64 < kend) prep_load(rb, W, N_src, k0 + 64, src_col, cv, lane);
        prep_chunk(ra, k0, ldd, g, b, dst, scr, lane, sg, sb);
        if (k0 + 64 < kend) {
            if (k0 + 128 < kend) prep_load(ra, W, N_src, k0 + 128, src_col, cv, lane);
            prep_chunk(rb, k0 + 64, ldd, g, b, dst, scr, lane, sg, sb);
        }
    }
    if (gWo) {
#pragma unroll
        for (int e = 0; e < 4; ++e) { sg[e] += __shfl_xor(sg[e], 8); sg[e] += __shfl_xor(sg[e], 16); sg[e] += __shfl_xor(sg[e], 32); sb[e] += __shfl_xor(sb[e], 8); sb[e] += __shfl_xor(sb[e], 16); sb[e] += __shfl_xor(sb[e], 32); }
        if (lane < 8) { *(f32x4*)(gWo + 4 * lane) = sg; *(f32x4*)(bWo + 4 * lane) = sb; }
    }
}
__device__ __forceinline__ int proj_src(int G, int& nvalid) {
    const int pn = G >> 3, gi = G & 7; nvalid = 32;
    if (pn < 11) { const int bj = gi >> 2, wc = gi & 3; int hb;
        if (pn < 2) hb = SC_QA + (4 * pn + wc) * 64; else if (pn < 4) hb = SC_KA + (4 * (pn - 2) + wc) * 64; else if (pn < 6) hb = SC_QB + (4 * (pn - 4) + wc) * 64;
        else if (pn < 8) hb = SC_QC + (4 * (pn - 6) + wc) * 64; else if (pn < 10) hb = SC_QI + (4 * (pn - 8) + wc) * 64;
        else hb = (wc == 0) ? SC_KB : (wc == 1) ? SC_KB + 64 : (wc == 2) ? SC_KC : SC_KI;
        return hb + 32 * bj; }
    if (pn < 13) return SC_VA + (pn - 11) * 256 + 32 * gi;
    if (gi < 4) return SC_VB + 32 * gi;
    if (gi < 6) return SC_VC + 32 * (gi - 4);
    if (gi == 6) { nvalid = 8; return SC_WI; }
    nvalid = 0; return 0;
}
constexpr int PREP_ITEMS = 176 + 128 + 112 + 96 + 96 + 32 + 176 + 128;
struct Ptrs {
    const float *x, *w_in, *sink, *w_out, *f1i, *f1o, *f2i, *f2o, *lng, *lnb; const int* pos;
    float *Y, *stats, *cosT, *sinT, *ones, *zeros, *aux, *LSE; bf16_t *Yb, *Wb, *BIG, *OB, *ACX;
};
__device__ __forceinline__ void prep_layer(const Ptrs& p, const float* const* inp, int l, LAS unsigned char* lds, int gw, int ngw, int wave, int lane) {
    LAS float* scr = (LAS float*)(lds + wave * 8448);
    const float* g_prev = (l == 0) ? nullptr : p.lng + (size_t)((l - 1) * 3 + 2) * D_; const float* b_prev = (l == 0) ? nullptr : p.lnb + (size_t)((l - 1) * 3 + 2) * D_;
    const float* g0 = p.lng + (size_t)(l * 3 + 0) * D_; const float* b0 = p.lnb + (size_t)(l * 3 + 0) * D_;
    const float* g1 = p.lng + (size_t)(l * 3 + 1) * D_; const float* b1 = p.lnb + (size_t)(l * 3 + 1) * D_;
    for (int it = gw; it < PREP_ITEMS; it += ngw) {
        int r = it;
        const float* W; int N_src, K, kbeg = 0, kend, src, nv = 32; const float* g = nullptr; const float* b = nullptr; bf16_t* dst; float* gWo = nullptr; float* bWo = nullptr;
        if (r < 176) { const int j = r >> 3, gi = r & 7; src = (gi < 4) ? 128 * j + 32 * gi : FF_ + 128 * j + 32 * (gi - 4);
            W = p.f1i + (size_t)l * D_ * 2 * FF_; N_src = 2 * FF_; K = D_; kend = D_; g = g_prev; b = b_prev; dst = p.Wb + WE_1 + (size_t)r * 32 * D_; gWo = p.aux + AUX_G1 + r * 32; bWo = p.aux + AUX_B1 + r * 32; }
        else if ((r -= 176) < 128) { const int rg = r >> 2, kq = r & 3; W = p.f1o + (size_t)l * FF_ * D_; N_src = D_; K = FF_; kbeg = 704 * kq; kend = kbeg + 704; src = 32 * rg; dst = p.Wb + WE_2 + (size_t)rg * 32 * FF_; }
        else if ((r -= 128) < 112) { src = proj_src(r, nv); W = p.w_in + (size_t)l * D_ * DIN_; N_src = DIN_; K = D_; kend = D_; g = g0; b = b0; dst = p.Wb + WE_3 + (size_t)r * 32 * D_; gWo = p.aux + AUX_G3 + r * 32; bWo = p.aux + AUX_B3 + r * 32; }
        else if ((r -= 112) < 96) { src = SC_G + 32 * r; W = p.w_in + (size_t)l * D_ * DIN_; N_src = DIN_; K = D_; kend = D_; g = g0; b = b0; dst = p.Wb + WE_4 + (size_t)r * 32 * D_; gWo = p.aux + AUX_G4 + r * 32; bWo = p.aux + AUX_B4 + r * 32; }
        else if ((r -= 96) < 96) { const int br = r >> 5; W = inp[4 + br] + (size_t)l * 512 * D_; N_src = D_; K = 1536; kend = 512; src = 32 * (r & 31); dst = p.Wb + WE_5 + (size_t)(32 * (r & 31)) * 1536 + br * 512; }
        else if ((r -= 96) < 32) { W = p.w_out + (size_t)l * D_ * D_; N_src = D_; K = D_; kend = D_; src = 32 * r; dst = p.Wb + WE_6 + (size_t)r * 32 * D_; }
        else if ((r -= 32) < 176) { const int j = r >> 3, gi = r & 7; src = (gi < 4) ? 128 * j + 32 * gi : FF_ + 128 * j + 32 * (gi - 4);
            W = p.f2i + (size_t)l * D_ * 2 * FF_; N_src = 2 * FF_; K = D_; kend = D_; g = g1; b = b1; dst = p.Wb + WE_7 + (size_t)r * 32 * D_; gWo = p.aux + AUX_G7 + r * 32; bWo = p.aux + AUX_B7 + r * 32; }
        else { r -= 176; const int rg = r >> 2, kq = r & 3; W = p.f2o + (size_t)l * FF_ * D_; N_src = D_; K = FF_; kbeg = 704 * kq; kend = kbeg + 704; src = 32 * rg; dst = p.Wb + WE_8 + (size_t)rg * 32 * FF_; }
        prep_item(W, N_src, K, kbeg, kend, src, nv, g, b, dst, gWo, bWo, scr, lane);
    }
}
__device__ const double ROPE_INV[32] = {1.0, 0.7498942093324559, 0.5623413251903491, 0.4216965034285822, 0.31622776601683794, 0.23713737056616552, 0.1778279410038923, 0.1333521432163324, 0.1, 0.07498942093324558, 0.05623413251903491, 0.042169650342858224, 0.03162277660168379, 0.023713737056616554, 0.01778279410038923, 0.01333521432163324, 0.01, 0.007498942093324558, 0.005623413251903491, 0.004216965034285823, 0.0031622776601683794, 0.0023713737056616554, 0.0017782794100389228, 0.001333521432163324, 0.001, 0.0007498942093324559, 0.0005623413251903491, 0.00042169650342858224, 0.00031622776601683794, 0.00023713737056616554, 0.00017782794100389227, 0.0001333521432163324};
__device__ __forceinline__ double rope_inv(int i) { return ROPE_INV[i]; }
__device__ __forceinline__ void prologue(const Ptrs& p, int gtid, int ngt) {
    for (size_t c = gtid; c < (size_t)T_ * D_ / 8; c += ngt) { const f32x4 a = *(const f32x4*)(p.x + c * 8), b = *(const f32x4*)(p.x + c * 8 + 4);
        *(u32x4*)(p.Yb + blk_off((int)(c >> 7), (int)(c & 127) * 8, D_)) = pack8(a, b); }
    for (size_t c = gtid; c < (size_t)T_ * 8; c += ngt) { f32x4 v = (f32x4){0.f, 0.f, 0.f, 0.f}; if ((c & 7) == 0) v[1] = 1024.0f * (1.0f - LN_EPS_); *(f32x4*)(p.stats + (size_t)T_ * 32 + c * 4) = v; }
    for (size_t c = gtid; c < (size_t)T_ * 32; c += ngt) { const int t = (int)(c >> 5), i = (int)(c & 31); const double ang = (double)p.pos[t] * rope_inv(i);
        const double rev = ang * 0.15915494309189535; const double fr = rev - rint(rev); const float r = (float)(fr * 6.283185307179586);
        p.cosT[c] = __cosf(r); p.sinT[c] = __sinf(r); }
    for (int c = gtid; c < D_; c += ngt) { p.ones[c] = 1.f; p.zeros[c] = 0.f; }
}
__device__ __forceinline__ void combine_a(const Ptrs& p, int gtid, int ngt) {
    for (size_t c = gtid; c < (size_t)T_ * 64; c += ngt) { const size_t t = c >> 6; const int j = (int)(c & 63), h = j >> 3;
        const float L0 = p.LSE[t * 8 + h], L1 = p.LSE[(size_t)T_ * 8 + t * 8 + h], L2 = p.LSE[(size_t)2 * T_ * 8 + t * 8 + h];
        const float mx = fmaxf(L0, fmaxf(L1, L2)); float w0 = fast_exp2(L0 - mx), w1 = fast_exp2(L1 - mx), w2 = fast_exp2(L2 - mx); const float inv = fast_rcp(w0 + w1 + w2); w0 *= inv; w1 *= inv; w2 *= inv;
        bf16_t* o0 = p.OB + t * NO_ + j * 8; const bf16_t* o1 = p.ACX + t * 512 + j * 8; const bf16_t* o2 = p.ACX + (size_t)T_ * 512 + t * 512 + j * 8;
        f32x4 a0, b0, a1, b1, a2, b2; unpack8(*(const u32x4*)o0, a0, b0); unpack8(*(const u32x4*)o1, a1, b1); unpack8(*(const u32x4*)o2, a2, b2);
        *(u32x4*)o0 = pack8(a0 * w0 + a1 * w1 + a2 * w2, b0 * w0 + b1 * w1 + b2 * w2); }
}
__device__ __forceinline__ void final_ln(const Ptrs& p, const float* st, const float* g, const float* b, int gw, int ngw, int lane) {
    for (int row = gw; row < T_; row += ngw) { float mu, rs; row_stats(st, row, lane >> 4, mu, rs);
#pragma unroll
        for (int j = 0; j < 4; ++j) { float* yp = p.Y + (size_t)row * D_ + 256 * j + 4 * lane; const f32x4 v = *(const f32x4*)yp, gg = *(const f32x4*)(g + 256 * j + 4 * lane), bb = *(const f32x4*)(b + 256 * j + 4 * lane);
            *(f32x4*)yp = ((v - mu) * rs) * gg + bb; } }
}


typedef unsigned short bf16;
#define XB_TMO      128
#define XB_XCNT(j)  (256  + 64 * (j))
#define XB_XSUB(j)  (1280 + 64 * (j))
#define XB_XGEN(j)  (2304 + 64 * (j))
#define XB_TOP      3328
#define XB_TOPGEN   3392
#define XCD_BAR_WORDS 3456
#define XB_SPIN_CAP (1u << 18)

__device__ __forceinline__ unsigned xb_ld(unsigned* p)              { return __hip_atomic_load(p, __ATOMIC_RELAXED, __HIP_MEMORY_SCOPE_AGENT); }
__device__ __forceinline__ unsigned xb_add(unsigned* p, unsigned v) { return __hip_atomic_fetch_add(p, v, __ATOMIC_RELAXED, __HIP_MEMORY_SCOPE_AGENT); }
__device__ __forceinline__ unsigned xb_xcc_id() { return (unsigned)__builtin_amdgcn_s_getreg((3 << 11) | 20) & 0xFu; }
#define XB_SPIN(cond, bar) do { unsigned _sp = 0; while (cond) { __builtin_amdgcn_s_sleep(1); \
    if ((++_sp & 255u) == 0u) { if (xb_ld(&(bar)[XB_TMO])) break; if (_sp > XB_SPIN_CAP) { atomicAdd(&(bar)[XB_TMO], 1u); break; } } } } while (0)

struct XcdBarrier {
    unsigned* bar; unsigned x;
    volatile LAS unsigned* st;
};

__device__ __forceinline__ XcdBarrier xcd_barrier_post(unsigned* bar, volatile LAS unsigned* st) {
    XcdBarrier b; b.bar = bar; b.x = xb_xcc_id(); b.st = st;
    if (threadIdx.x == 0) (void)xb_add(&bar[XB_XCNT(b.x)], 1u);
    return b;
}
__device__ __forceinline__ void xcd_barrier_complete(unsigned* bar, unsigned x, unsigned& nloc, unsigned& nx) {
    const unsigned G = gridDim.x * gridDim.y * gridDim.z;
    unsigned sum, cnt, mine, sp = 0u;
    for (;;) {
        sum = 0u; cnt = 0u; mine = 0u;
#pragma unroll
        for (unsigned j = 0; j < 16; ++j) { const unsigned c = xb_ld(&bar[XB_XCNT(j)]); sum += c; cnt += (c > 0u) ? 1u : 0u; mine = (j == x) ? c : mine; }
        if (sum == G) break;
        __builtin_amdgcn_s_sleep(1);
        if ((++sp & 255u) == 0u) { if (xb_ld(&bar[XB_TMO])) break; if (sp > XB_SPIN_CAP) { atomicAdd(&bar[XB_TMO], 1u); break; } }
    }
    nloc = mine > 0u ? mine : 1u; nx = cnt > 0u ? cnt : 1u;
}

__device__ __forceinline__ void xcd_barrier(const XcdBarrier& b) {
    asm volatile("s_waitcnt vmcnt(0)" ::: "memory");
    __syncthreads();
    if (threadIdx.x == 0) {
        unsigned* bar = b.bar;
        __builtin_amdgcn_s_waitcnt(0);
        unsigned nloc = b.st[0], nx = b.st[1];
        if (nloc == 0u) { xcd_barrier_complete(bar, b.x, nloc, nx); b.st[0] = nloc; b.st[1] = nx; }
        const unsigned old = xb_add(&bar[XB_XSUB(b.x)], 1u);
        const unsigned gen = old / nloc;
        if (old + 1u == (gen + 1u) * nloc) {
            __builtin_amdgcn_fence(__ATOMIC_RELEASE, "agent");
            asm volatile("s_waitcnt vmcnt(0)" ::: "memory");
            const unsigned og = xb_add(&bar[XB_TOP], 1u);
            const unsigned tg = og / nx;
            if (og + 1u == (tg + 1u) * nx) xb_add(&bar[XB_TOPGEN], 1u);
            else XB_SPIN(xb_ld(&bar[XB_TOPGEN]) == tg, bar);
            __builtin_amdgcn_fence(__ATOMIC_ACQUIRE, "agent");
            xb_add(&bar[XB_XGEN(b.x)], 1u);
            asm volatile("s_waitcnt vmcnt(0)" ::: "memory");
        } else {
            XB_SPIN(xb_ld(&bar[XB_XGEN(b.x)]) == gen, bar);
            __builtin_amdgcn_fence(__ATOMIC_ACQUIRE, "agent");
            asm volatile("s_waitcnt vmcnt(0)" ::: "memory");
        }
    }
    __syncthreads();
}

constexpr int NWAVES = 8, LDS_BYTES = 131072 + 256, LDS_MISC = 131072;
constexpr size_t WS_CTL = 16 * MiB + 512 * 1024, CTL_BYTES = 16384;
#ifndef DSA_REPS
#define DSA_REPS 1
#endif
#ifndef BAND_REPS
#define BAND_REPS 1
#endif
#ifndef BAND_NQ
#define BAND_NQ 2
#endif
#ifndef G6_REPS
#define G6_REPS 1
#endif
#ifndef ATT_REPS
#define ATT_REPS 1
#endif
#ifndef PREP_REPS
#define PREP_REPS 1
#endif
constexpr int NPHASE = 10 * DEPTH_ + 1;
static_assert(C_LDS_END <= LDS_BYTES && 8 * 8448 <= LDS_BYTES, "LDS map");
struct Args { const float* in[14]; float* out; unsigned char* ws; int lo, hi; };
__global__ void __launch_bounds__(NWAVES * 64, 2) mega(Args a) {
    extern __shared__ __attribute__((aligned(16))) unsigned char lds_raw[];
    LAS unsigned char* lds = (LAS unsigned char*)lds_raw;
    const int wave = __builtin_amdgcn_readfirstlane((int)threadIdx.x >> 6);
#define OTID() ({ int t_ = threadIdx.x; asm volatile("" : "+v"(t_)); t_; })
#define LANE() (OTID() & 63)
#define GTID() (vcu * NWAVES * 64 + OTID())
    const int G = gridDim.x, bx = blockIdx.x, vcu = (G % 8 == 0) ? (bx % 8) * (G / 8) + bx / 8 : bx;
    const int gw = vcu * NWAVES + wave, ngw = G * NWAVES, ngt = G * NWAVES * 64;
    Ptrs p;
    p.x = a.in[0]; p.pos = (const int*)a.in[1]; p.w_in = a.in[2]; p.sink = a.in[3];  p.w_out = a.in[7];
    p.f1i = a.in[8]; p.f1o = a.in[9]; p.f2i = a.in[10]; p.f2o = a.in[11]; p.lng = a.in[12]; p.lnb = a.in[13];
    unsigned char* ws = a.ws;
    p.Y = a.out; p.stats = (float*)(ws + WS_STATS); p.cosT = (float*)(ws + WS_ROPE); p.sinT = p.cosT + (size_t)T_ * 32; p.ones = (float*)(ws + WS_LNV); p.zeros = p.ones + 1024;
    p.aux = (float*)(ws + WS_AUX); p.LSE = (float*)(ws + WS_LSE); p.Yb = (bf16_t*)(ws + WS_YB); p.Wb = (bf16_t*)(ws + WS_W); p.BIG = (bf16_t*)(ws + WS_BIG); p.OB = (bf16_t*)(ws + WS_OBUF); p.ACX = (bf16_t*)(ws + WS_ACX);
#if !MK_MULTI
    cg::grid_group grid = cg::this_grid();
    if (threadIdx.x < 64) ((LAS unsigned*)(lds + LDS_MISC))[threadIdx.x] = 0u;
    __syncthreads();
    XcdBarrier xbar = xcd_barrier_post((unsigned*)(a.ws + WS_CTL), (volatile LAS unsigned*)(lds + LDS_MISC));
#endif
    const int lo = a.lo, hi = a.hi;
#define IN(k) (lo <= (k) && (k) < hi)
#if MK_MULTI
#define SEAM(k) do { } while (0)
#else
#define SEAM(k) do { if (IN(k) && IN((k) + 1)) { if ((k) == 0) grid.sync(); else xcd_barrier(xbar); } } while (0)
#endif
    for (int l = 0; l < DEPTH_; ++l) {
        const int pb = 10 * l;
        const int s0 = 3 * l;
        const float* gp; const float* bp;
        if (IN(pb + 0)) for (int rep_ = 0; rep_ < PREP_REPS; ++rep_) {
#ifndef NO_PREP
 prep_layer(p, a.in, l, lds, gw, ngw, wave, LANE()); if (l == 0) prologue(p, GTID(), ngt);
#endif
 }
        SEAM(pb + 0);
        if (IN(pb + 1)) {
#ifndef NO_G1
 pg8::Gemm g{p.Yb, p.Wb + WE_1, 64, D_, 1}; pg8::StaticOrder S; S.init(T_, 2 * FF_, G, bx);
            EpiSwiglu E{p.BIG, p.stats + (size_t)((s0 + 1) & 1) * T_ * 32, p.aux + AUX_G1, p.aux + AUX_B1};
            pg8::gemm_phase<EpiSwiglu, pg8::StaticOrder, true, true>(lds, g, S, E);
#endif
        }
        SEAM(pb + 1);
        if (IN(pb + 2)) {
#ifndef NO_G2
 pg8::Gemm g{p.BIG, p.Wb + WE_2, 64, FF_, 1}; pg8::StaticOrder S; S.init(T_, D_, G, bx);
            gp = (l == 0) ? p.ones : p.lng + (size_t)((l - 1) * 3 + 2) * D_; bp = (l == 0) ? p.zeros : p.lnb + (size_t)((l - 1) * 3 + 2) * D_;
            EpiResid E{(l == 0) ? p.x : p.Y, p.Y, p.Yb, p.stats + (size_t)((s0 + 1) & 1) * T_ * 32, p.stats + (size_t)(s0 & 1) * T_ * 32, gp, bp, 0.5f};
            pg8::gemm_phase<EpiResid, pg8::StaticOrder, true, true>(lds, g, S, E);
#endif
        }
        SEAM(pb + 2);
        if (IN(pb + 3)) {
#ifndef NO_G3
 pg8::Gemm g{p.Yb, p.Wb + WE_3, 64, D_, 1}; pg8::StaticOrder S; S.init(T_, NP_, G, bx);
            EpiProj E{p.BIG, p.stats + (size_t)(s0 & 1) * T_ * 32, p.aux + AUX_G3, p.aux + AUX_B3, p.cosT, p.sinT};
            pg8::gemm_phase<EpiProj, pg8::StaticOrder, true, true>(lds, g, S, E);
#endif
        }
        SEAM(pb + 3);
        if (IN(pb + 4)) for (int rep_ = 0; rep_ < ATT_REPS; ++rep_) {
#ifndef NO_DSA
            for (int dr_ = 0; dr_ < DSA_REPS; ++dr_) for (int idx = vcu; idx < NB_ * 128; idx += G) { const int k = idx >> 8, v = idx & 255, b = (v >> 5) + 8 * (k & 1), c32 = v & 31, k2 = k >> 1, blk = 32 * k2 + ((k2 & 1) ? 31 - c32 : c32);
                dsa_unit(b, blk, p.BIG, p.OB, lds, wave, OTID()); }
#endif
#ifndef NO_BAND
            LAS unsigned char* vl = lds + C_VST + wave * 4096;
            for (int br_ = 0; br_ < BAND_REPS; ++br_) for (int u = gw; u < 4 * NB_ * 8 * (SEQ_ / (16 * BAND_NQ)); u += ngw) band_unit<BAND_NQ>(u, p.BIG, p.OB, p.ACX, p.LSE, p.sink + l * 8, vl, LANE());
#endif
        }
        SEAM(pb + 4);
        if (IN(pb + 5)) {
#ifndef NO_G5
 combine_a(p, GTID(), ngt);
            pg8::Gemm g{p.Yb, p.Wb + WE_4, 64, D_, 1}; pg8::StaticOrder S; S.init(T_, NG_, G, bx);
            EpiGate E{p.BIG, p.stats + (size_t)(s0 & 1) * T_ * 32, p.aux + AUX_G4, p.aux + AUX_B4};
            pg8::gemm_phase<EpiGate, pg8::StaticOrder, true, true>(lds, g, S, E);
#endif
        }
        SEAM(pb + 5);
        if (IN(pb + 6)) for (int rep_ = 0; rep_ < G6_REPS; ++rep_) {
#ifndef NO_G6
 pg8::Gemm g{p.OB, p.Wb + WE_5, NO_, NO_, 0}; pg8::StaticOrder S; S.init(T_, D_, G, bx);
            EpiBranch E{p.BIG, p.ACX};
            pg8::gemm_phase<EpiBranch, pg8::StaticOrder, true, true>(lds, g, S, E);
#endif
        }
        SEAM(pb + 6);
        if (IN(pb + 7)) {
#ifndef NO_G7
 pg8::Gemm g{p.ACX, p.Wb + WE_6, 64, D_, 1}; pg8::StaticOrder S; S.init(T_, D_, G, bx);
            EpiResid E{p.Y, p.Y, p.Yb, p.stats + (size_t)(s0 & 1) * T_ * 32, p.stats + (size_t)((s0 + 1) & 1) * T_ * 32, p.lng + (size_t)(l * 3 + 0) * D_, p.lnb + (size_t)(l * 3 + 0) * D_, 1.0f};
            pg8::gemm_phase<EpiResid, pg8::StaticOrder, true, true>(lds, g, S, E);
#endif
        }
        SEAM(pb + 7);
        if (IN(pb + 8)) {
#ifndef NO_G8
 pg8::Gemm g{p.Yb, p.Wb + WE_7, 64, D_, 1}; pg8::StaticOrder S; S.init(T_, 2 * FF_, G, bx);
            EpiSwiglu E{p.BIG, p.stats + (size_t)((s0 + 1) & 1) * T_ * 32, p.aux + AUX_G7, p.aux + AUX_B7};
            pg8::gemm_phase<EpiSwiglu, pg8::StaticOrder, true, true>(lds, g, S, E);
#endif
        }
        SEAM(pb + 8);
        if (IN(pb + 9)) {
#ifndef NO_G9
 pg8::Gemm g{p.BIG, p.Wb + WE_8, 64, FF_, 1}; pg8::StaticOrder S; S.init(T_, D_, G, bx);
            EpiResid E{p.Y, p.Y, p.Yb, p.stats + (size_t)((s0 + 1) & 1) * T_ * 32, p.stats + (size_t)(s0 & 1) * T_ * 32, p.lng + (size_t)(l * 3 + 1) * D_, p.lnb + (size_t)(l * 3 + 1) * D_, 0.5f};
            pg8::gemm_phase<EpiResid, pg8::StaticOrder, true, true>(lds, g, S, E);
#endif
        }
        SEAM(pb + 9);
    }
    if (IN(10 * DEPTH_)) final_ln(p, p.stats + (size_t)T_ * 32, p.lng + (size_t)((DEPTH_ - 1) * 3 + 2) * D_, p.lnb + (size_t)((DEPTH_ - 1) * 3 + 2) * D_, gw, ngw, LANE());
#undef IN
#undef SEAM
}

extern "C" void kernel_launch(void* const* d_in, const int* in_sizes, int n_in, void* d_out, int out_size, void* d_ws, size_t ws_size, hipStream_t stream) {
    static int grid = 0;
    if (grid == 0) {
        if (n_in != 14 || in_sizes[0] != T_ * D_ || out_size != T_ * D_ || ws_size < WS_END) { fprintf(stderr, "kernel_launch: unexpected shapes/workspace (n_in %d, ws %zu, need %zu)\n", n_in, ws_size, (size_t)WS_END); grid = -1; return; }
        int dev = 0, cus = 0, per_cu = 0;
        if (hipGetDevice(&dev) != hipSuccess || hipDeviceGetAttribute(&cus, hipDeviceAttributeMultiprocessorCount, dev) != hipSuccess) { grid = -1; return; }
        if (hipFuncSetAttribute((const void*)mega, hipFuncAttributeMaxDynamicSharedMemorySize, LDS_BYTES) != hipSuccess) { fprintf(stderr, "kernel_launch: hipFuncSetAttribute failed\n"); grid = -1; return; }
        if (hipOccupancyMaxActiveBlocksPerMultiprocessor(&per_cu, (const void*)mega, NWAVES * 64, LDS_BYTES) != hipSuccess || per_cu < 1) { fprintf(stderr, "kernel_launch: occupancy query says %d\n", per_cu); per_cu = 1; }
        (void)hipGetLastError();
        grid = cus * 1;
    }
    if (grid < 0) return;
    Args a{};
    for (int i = 0; i < 14; ++i) a.in[i] = (const float*)d_in[i];
    a.out = (float*)d_out; a.ws = (unsigned char*)d_ws;
#if MK_MULTI
    for (int ph = 0; ph < NPHASE; ++ph) { a.lo = ph; a.hi = ph + 1; hipLaunchKernelGGL(mega, dim3(grid), dim3(NWAVES * 64), LDS_BYTES, stream, a); }
#else
    a.lo = 0; a.hi = NPHASE;
    if (hipMemsetAsync((char*)d_ws + WS_CTL, 0, CTL_BYTES, stream) != hipSuccess) { fprintf(stderr, "kernel_launch: memset failed\n"); return; }
    void* args[] = {&a};
    hipError_t e = hipLaunchCooperativeKernel((const void*)mega, dim3(grid), dim3(NWAVES * 64), args, LDS_BYTES, stream);
    if (e != hipSuccess) fprintf(stderr, "kernel_launch: cooperative launch failed: %s (grid %d)\n", hipGetErrorString(e), grid);
#endif
}
```

```cpp
#define BAND_NQ 4
#include <hip/hip_runtime.h>
#include <hip/hip_cooperative_groups.h>
#include <cstdio>
#include <cstdint>
namespace cg = cooperative_groups;

#ifndef MK_MULTI
#define MK_MULTI 0
#endif

constexpr int T_ = 32768, D_ = 1024, FF_ = 2816, SEQ_ = 2048, NB_ = 16, DEPTH_ = 4;
constexpr int NP_ = 3584, NG_ = 3072, NO_ = 1536, DIN_ = 6600;
constexpr float LN_EPS_ = 1e-5f;
constexpr float ALPHA_ = 1.6817928305074292f;
constexpr float SC2_ = 0.125f * 1.4426950408889634f;
constexpr int PC_QA = 0, PC_KA = 512, PC_QB = 1024, PC_QC = 1536, PC_QI = 2048, PC_KB = 2560, PC_KC = 2688, PC_KI = 2752, PC_VA = 2816, PC_VB = 3328, PC_VC = 3456, PC_WI = 3520;
constexpr int SC_QA = 0, SC_KA = 512, SC_VA = 1024, SC_QB = 1536, SC_KB = 2048, SC_VB = 2176, SC_QC = 2304, SC_KC = 2816, SC_VC = 2880, SC_QI = 2944, SC_KI = 3456, SC_WI = 3520, SC_G = 3528;

constexpr size_t MiB = 1u << 20;
constexpr size_t WS_STATS = 0;
constexpr size_t WS_ROPE  = 8 * MiB;
constexpr size_t WS_LNV   = 16 * MiB;
constexpr size_t WS_AUX   = WS_LNV + 8192;
constexpr int AUX_G1 = 0, AUX_B1 = 5632, AUX_G3 = 11264, AUX_B3 = 14848, AUX_G4 = 18432, AUX_B4 = 21504, AUX_G7 = 24576, AUX_B7 = 30208, AUX_END = 35840;
constexpr size_t WS_LSE   = 17 * MiB;
constexpr size_t WS_YB    = 20 * MiB;
constexpr size_t WS_W     = 84 * MiB;
constexpr size_t WE_1 = 0, WE_2 = WE_1 + (size_t)5632 * 1024, WE_3 = WE_2 + (size_t)1024 * 2816, WE_4 = WE_3 + (size_t)3584 * 1024, WE_5 = WE_4 + (size_t)3072 * 1024,
                 WE_6 = WE_5 + (size_t)3072 * 512, WE_7 = WE_6 + (size_t)1024 * 1024, WE_8 = WE_7 + (size_t)5632 * 1024, WE_END = WE_8 + (size_t)1024 * 2816;
static_assert(WE_END * 2 <= 52 * MiB, "weights");
constexpr size_t WS_BIG   = 136 * MiB;
constexpr size_t WS_OBUF  = 360 * MiB;
constexpr size_t WS_ACX   = 456 * MiB;
constexpr size_t WS_END   = 520 * MiB;
static_assert(WS_AUX + AUX_END * 4 <= WS_LSE && WS_LSE + 3 * MiB <= WS_YB && WS_BIG + (size_t)T_ * NP_ * 2 <= WS_OBUF, "ws map");

#define LAS __attribute__((address_space(3)))
typedef unsigned short bf16_t;
typedef short bf16x8 __attribute__((ext_vector_type(8)));
typedef short s16x4 __attribute__((ext_vector_type(4)));
typedef float f32x4 __attribute__((ext_vector_type(4)));
typedef float f32x2 __attribute__((ext_vector_type(2)));
typedef unsigned u32x4 __attribute__((ext_vector_type(4)));
typedef unsigned u32x2 __attribute__((ext_vector_type(2)));
__device__ __forceinline__ unsigned f2bf(float f) { unsigned u = __float_as_uint(f); return (u + 0x7fffu + ((u >> 16) & 1u)) >> 16; }
__device__ __forceinline__ float bf2f(unsigned v) { return __uint_as_float(v << 16); }
typedef __bf16 bf16x2_t __attribute__((ext_vector_type(2)));
__device__ __forceinline__ unsigned cvt_pk_bf16(float lo, float hi) { const f32x2 v = {lo, hi}; const bf16x2_t b = __builtin_convertvector(v, bf16x2_t); return __builtin_bit_cast(unsigned, b); }
__device__ __forceinline__ float fast_exp2(float x) { return __builtin_amdgcn_exp2f(x); }
__device__ __forceinline__ float fast_rcp(float x) { return __builtin_amdgcn_rcpf(x); }
__device__ __forceinline__ float xmax16(float v) { const auto r = __builtin_amdgcn_permlane16_swap(__float_as_uint(v), __float_as_uint(v), false, false); return fmaxf(__uint_as_float(r[0]), __uint_as_float(r[1])); }
__device__ __forceinline__ float xmax32(float v) { const auto r = __builtin_amdgcn_permlane32_swap(__float_as_uint(v), __float_as_uint(v), false, false); return fmaxf(__uint_as_float(r[0]), __uint_as_float(r[1])); }
__device__ __forceinline__ float xsum16(float v) { const auto r = __builtin_amdgcn_permlane16_swap(__float_as_uint(v), __float_as_uint(v), false, false); return __uint_as_float(r[0]) + __uint_as_float(r[1]); }
__device__ __forceinline__ float xsum32(float v) { const auto r = __builtin_amdgcn_permlane32_swap(__float_as_uint(v), __float_as_uint(v), false, false); return __uint_as_float(r[0]) + __uint_as_float(r[1]); }
__device__ __forceinline__ float sigmoid_f(float x) { return fast_rcp(1.0f + fast_exp2(-1.4426950408889634f * x)); }
__device__ __forceinline__ void row_stats(const float* st, int row, int fq, float& mu, float& rstd) {
    const f32x4* p = (const f32x4*)(st + (size_t)row * 32 + fq * 8);
    const f32x4 a = p[0], b = p[1];
    float s1 = (a[0] + a[2]) + (b[0] + b[2]), s2 = (a[1] + a[3]) + (b[1] + b[3]);
    s1 = xsum32(xsum16(s1)); s2 = xsum32(xsum16(s2));
    mu = s1 * (1.0f / 1024.0f); const float var = fmaxf(s2 * (1.0f / 1024.0f) - mu * mu, 0.f); rstd = rsqrtf(var + LN_EPS_);
}

__device__ __forceinline__ size_t blk_off(int r, int c, int K) { return (size_t)(r >> 8) * 256 * K + (size_t)(c >> 6) * (256 * 64) + (size_t)((r & 255) * 64 + (c & 63)); }

namespace pg8 {
#define PG8_LAS __attribute__((address_space(3)))
constexpr int BM = 256, BK = 64, HALF = 128, HTB = HALF * BK * 2, STAGE_BYTES = 8 * HTB, NXCD = 8, WGM = 8;
__host__ __device__ __forceinline__ int lds_byte(int r, int c) { const int st = (r >> 4) * 2 + (c >> 5), rr = r & 15, cc = c & 31, ob = rr * 64 + cc * 2; return st * 1024 + (ob ^ (((ob >> 9) & 1) << 5)); }
__host__ __device__ __forceinline__ void stage_rc(int b, int& R, int& C) { const int st = b / 1024, sb = b % 1024, swz = sb ^ (((sb >> 9) & 1) << 5); R = (st >> 1) * 16 + swz / 64; C = (st & 1) * 32 + (swz % 64) / 2; }
__host__ __device__ __forceinline__ int perm32(int rho) { const int n = rho >> 4, i = rho & 15; return 8 * (i >> 2) + 4 * n + (i & 3); }
struct Unit { int pm, pn, ac; };
struct Gemm { const bf16_t* A; const bf16_t* Bt; int lda, K, blk; };
struct StaticOrder {
    int nM, nN, nwg, G, c;
    __device__ void init(int M, int N, int G_, int c_) { nM = M / BM; nN = N / BM; nwg = nM * nN; G = G_; c = c_; }
    __device__ bool next(int i, Unit& u) const {
        const long L = (long)i * G + c; if (L >= nwg) return false;
        int wgid = (int)L; { const int q = nwg / NXCD, r = nwg % NXCD, xcd = wgid % NXCD, off = wgid / NXCD; wgid = (xcd < r ? xcd * (q + 1) : r * (q + 1) + (xcd - r) * q) + off; }
        const int nig = WGM * nN, gid = wgid / nig, fm = gid * WGM, gsz = (nM - fm) < WGM ? (nM - fm) : WGM;
        u.pm = fm + ((wgid % nig) % gsz); u.pn = (wgid % nig) / gsz; u.ac = 0; return true;
    }
    __device__ __forceinline__ void a_ready(const Unit&) const {}
    __device__ __forceinline__ void done(const Unit&) const {}
};
struct BranchOrder {
    StaticOrder so;
    __device__ void init(int G_, int c_) { so.init(T_, 1024, G_, c_); }
    __device__ bool next(int i, Unit& u) const { const int br = i % 3; if (!so.next(i / 3, u)) return false; u.pn += 4 * br; u.ac = br * 512 * 2; return true; }
    __device__ __forceinline__ void a_ready(const Unit&) const {}
    __device__ __forceinline__ void done(const Unit&) const {}
};
template <class Epi, class Sched, bool ALIGN_EPI = false, bool SP2 = false>
__device__ __forceinline__ void gemm_phase(PG8_LAS unsigned char* lds, const Gemm g, const Sched& S, const Epi& E) {
    int tid_ = threadIdx.x; asm volatile("" : "+v"(tid_));
    const int tid = tid_, wid = __builtin_amdgcn_readfirstlane(tid >> 6), lane = tid & 63, wr = wid >> 2, wc = wid & 3, fr = lane & 15, fq = lane >> 4;
    const int K = g.K, nt = K / BK, LDA = g.lda;
    unsigned voffA[2], voffB[2];
#pragma unroll
    for (int i = 0; i < 2; ++i) { int R, C; stage_rc(tid * 16 + i * 8192, R, C); const int Rb = Epi::PERM ? ((R & ~31) + perm32(R & 31)) : R;
        voffA[i] = (unsigned)(R * LDA + C) * 2u; voffB[i] = (unsigned)(Rb * K + C) * 2u; }
    const size_t kstepB = (size_t)(BK * 2), kstepA = g.blk ? (size_t)(BM * BK * 2) : kstepB;
    const size_t hstepB = (size_t)HALF * K * 2, hstepA = (size_t)HALF * LDA * 2;
    const size_t tstepA = g.blk ? (size_t)BM * K * 2 : 2 * hstepA, tstepB = 2 * hstepB;
    const unsigned ldsw = (unsigned)wid * 1024u;
    const int aoff = lds_byte(wr * 64 + fr, fq * 8), boff = lds_byte(wc * 32 + fr, fq * 8);
#define PG8_SA(b, h) (((b) * 2 + (h)) * HTB)
#define PG8_SB(b, h) ((4 + (b) * 2 + (h)) * HTB)
#define PG8_STAGE(bufoff, gbase, voff) do { _Pragma("unroll") for (int _i = 0; _i < 2; ++_i) \
        __builtin_amdgcn_global_load_lds((const unsigned*)((const char*)(gbase) + (voff)[_i]), (PG8_LAS unsigned*)(lds + (bufoff) + ldsw + _i * 8192), 16, 0, 0); } while (0)
#define PG8_LDA(dst, b, h) do { _Pragma("unroll") for (int m = 0; m < 4; ++m) _Pragma("unroll") for (int k = 0; k < 2; ++k) dst[m][k] = *(const PG8_LAS bf16x8*)(lds + PG8_SA(b, h) + aoff + m * 2048 + k * 1024); } while (0)
#define PG8_LDB(dst, b, h) do { _Pragma("unroll") for (int n = 0; n < 2; ++n) _Pragma("unroll") for (int k = 0; k < 2; ++k) dst[n][k] = *(const PG8_LAS bf16x8*)(lds + PG8_SB(b, h) + boff + n * 2048 + k * 1024); } while (0)
#define PG8_MMA(ai, bj, At, Bt) do { __builtin_amdgcn_s_setprio(1); _Pragma("unroll") for (int m = 0; m < 4; ++m) _Pragma("unroll") for (int n = 0; n < 2; ++n) _Pragma("unroll") for (int k = 0; k < 2; ++k) \
        acc[ai][bj][m][n] = __builtin_amdgcn_mfma_f32_16x16x32_bf16(Bt[n][k], At[m][k], acc[ai][bj][m][n], 0, 0, 0); __builtin_amdgcn_s_setprio(0); } while (0)
#define PG8_WAIT_V(n) asm volatile("s_waitcnt vmcnt(" #n ")" ::: "memory")
#define PG8_WAIT_L(n) asm volatile("s_waitcnt lgkmcnt(" #n ")" ::: "memory")
#define PG8_BAR __builtin_amdgcn_s_barrier()
#define PG8_SCHED __builtin_amdgcn_sched_barrier(0)
    Unit cur, nxt; int ui = 0;
    if (!S.next(0, cur)) return;
    f32x4 acc[2][2][4][2];
#pragma unroll
    for (int a = 0; a < 2; ++a)
#pragma unroll
        for (int b = 0; b < 2; ++b)
#pragma unroll
            for (int m = 0; m < 4; ++m)
#pragma unroll
                for (int n = 0; n < 2; ++n) acc[a][b][m][n] = (f32x4){0.f, 0.f, 0.f, 0.f};
    bf16x8 At[4][2], B0[2][2], B1[2][2];
    const char* cA = (const char*)g.A + (size_t)cur.pm * tstepA + cur.ac; const char* cB = (const char*)g.Bt + (size_t)cur.pn * tstepB;
    S.a_ready(cur);
    if constexpr (SP2) {
        PG8_STAGE(PG8_SB(0, 0), cB, voffB); PG8_STAGE(PG8_SB(0, 1), cB + hstepB, voffB); PG8_STAGE(PG8_SA(0, 0), cA, voffA); PG8_STAGE(PG8_SA(0, 1), cA + hstepA, voffA);
        if (wr == 1) PG8_BAR;
        PG8_WAIT_V(2); PG8_BAR;
        PG8_STAGE(PG8_SB(1, 0), cB + kstepB, voffB); PG8_STAGE(PG8_SA(1, 0), cA + kstepA, voffA); PG8_STAGE(PG8_SB(1, 1), cB + hstepB + kstepB, voffB);
        PG8_WAIT_V(6); PG8_BAR;
    } else {
        PG8_STAGE(PG8_SB(0, 0), cB, voffB); PG8_STAGE(PG8_SA(0, 0), cA, voffA); PG8_STAGE(PG8_SB(0, 1), cB + hstepB, voffB); PG8_STAGE(PG8_SA(0, 1), cA + hstepA, voffA);
        if (wr == 1) PG8_BAR;
        PG8_WAIT_V(4); PG8_BAR;
        PG8_STAGE(PG8_SB(1, 0), cB + kstepB, voffB); PG8_STAGE(PG8_SA(1, 0), cA + kstepA, voffA); PG8_STAGE(PG8_SB(1, 1), cB + hstepB + kstepB, voffB);
        PG8_WAIT_V(6); PG8_BAR;
    }
    for (;;) {
        const bool has_next = S.next(ui + 1, nxt);
        const char* nA = has_next ? (const char*)g.A + (size_t)nxt.pm * tstepA + nxt.ac : cA; const char* nB = has_next ? (const char*)g.Bt + (size_t)nxt.pn * tstepB : cB;
        for (int t = 0; t < nt; t += 2) {
            if constexpr (Epi::MIDK) { if (t == 8 || t == 16) E.mid(acc, cur, t, wr, wc, fr, fq); }
            const bool last = (t == nt - 2);
            const char* a1 = cA + (size_t)(t + 1) * kstepA;
            const char* a2 = last ? nA : cA + (size_t)(t + 2) * kstepA; const char* b2 = last ? nB : cB + (size_t)(t + 2) * kstepB;
            const char* a3 = a2 + kstepA; const char* b3 = b2 + kstepB;
            if (last && has_next) S.a_ready(nxt);
            if constexpr (SP2) {
            PG8_LDB(B0, 0, 0); PG8_LDB(B1, 0, 1); PG8_SCHED; PG8_LDA(At, 0, 0); PG8_STAGE(PG8_SA(1, 1), a1 + hstepA, voffA);
            PG8_WAIT_V(8); PG8_WAIT_L(0); PG8_BAR; PG8_MMA(0, 0, At, B0); PG8_MMA(0, 1, At, B1); PG8_BAR; PG8_SCHED;
            PG8_LDA(At, 0, 1); PG8_STAGE(PG8_SB(0, 0), b2, voffB); PG8_STAGE(PG8_SB(0, 1), b2 + hstepB, voffB); PG8_STAGE(PG8_SA(0, 0), a2, voffA);
            PG8_WAIT_V(8); PG8_WAIT_L(0); PG8_BAR; PG8_MMA(1, 0, At, B0); PG8_MMA(1, 1, At, B1); PG8_BAR; PG8_SCHED;
            PG8_LDB(B0, 1, 0); PG8_LDB(B1, 1, 1); PG8_SCHED; PG8_LDA(At, 1, 0); PG8_STAGE(PG8_SA(0, 1), a2 + hstepA, voffA);
            PG8_WAIT_V(8); PG8_WAIT_L(0); PG8_BAR; PG8_MMA(0, 0, At, B0); PG8_MMA(0, 1, At, B1); PG8_BAR; PG8_SCHED;
            PG8_LDA(At, 1, 1); PG8_STAGE(PG8_SB(1, 0), b3, voffB); PG8_STAGE(PG8_SB(1, 1), b3 + hstepB, voffB); PG8_STAGE(PG8_SA(1, 0), a3, voffA);
            PG8_WAIT_V(8); PG8_WAIT_L(0); PG8_BAR; PG8_MMA(1, 0, At, B0); PG8_MMA(1, 1, At, B1); PG8_BAR; PG8_SCHED;
            } else {
            PG8_LDB(B0, 0, 0); PG8_SCHED; PG8_LDA(At, 0, 0); PG8_STAGE(PG8_SA(1, 1), a1 + hstepA, voffA);
            PG8_WAIT_L(8); PG8_BAR; PG8_WAIT_L(0); PG8_MMA(0, 0, At, B0); PG8_BAR; PG8_SCHED;
            PG8_LDB(B1, 0, 1); PG8_STAGE(PG8_SB(0, 0), b2, voffB);
            PG8_BAR; PG8_WAIT_L(0); PG8_MMA(0, 1, At, B1); PG8_BAR;
            PG8_LDA(At, 0, 1); PG8_STAGE(PG8_SA(0, 0), a2, voffA);
            PG8_BAR; PG8_WAIT_L(0); PG8_MMA(1, 0, At, B0); PG8_BAR; PG8_SCHED;
            PG8_STAGE(PG8_SB(0, 1), b2 + hstepB, voffB);
            PG8_WAIT_V(6); PG8_BAR; PG8_MMA(1, 1, At, B1); PG8_BAR;
            PG8_LDB(B0, 1, 0); PG8_SCHED; PG8_LDA(At, 1, 0); PG8_STAGE(PG8_SA(0, 1), a2 + hstepA, voffA);
            PG8_WAIT_L(8); PG8_BAR; PG8_WAIT_L(0); PG8_MMA(0, 0, At, B0); PG8_BAR; PG8_SCHED;
            PG8_LDB(B1, 1, 1); PG8_STAGE(PG8_SB(1, 0), b3, voffB);
            PG8_BAR; PG8_WAIT_L(0); PG8_MMA(0, 1, At, B1); PG8_BAR;
            PG8_LDA(At, 1, 1); PG8_STAGE(PG8_SA(1, 0), a3, voffA);
            PG8_BAR; PG8_WAIT_L(0); PG8_MMA(1, 0, At, B0); PG8_BAR; PG8_SCHED;
            PG8_STAGE(PG8_SB(1, 1), b3 + hstepB, voffB);
            PG8_WAIT_V(6); PG8_BAR; PG8_MMA(1, 1, At, B1); PG8_BAR;
            }
        }
        if constexpr (ALIGN_EPI) { if (wr == 0) PG8_BAR; }
        if constexpr (!Epi::AFTER_DRAIN) { E(acc, cur, wr, wc, fr, fq); S.done(cur); }
        if (!has_next) break;
#pragma unroll
        for (int a = 0; a < 2; ++a)
#pragma unroll
            for (int b = 0; b < 2; ++b)
#pragma unroll
                for (int m = 0; m < 4; ++m)
#pragma unroll
                    for (int n = 0; n < 2; ++n) acc[a][b][m][n] = (f32x4){0.f, 0.f, 0.f, 0.f};
        cur = nxt; cA = nA; cB = nB; ++ui;
        if constexpr (ALIGN_EPI) { if (wr == 1) PG8_BAR; }
    }
    PG8_WAIT_V(0);
    if constexpr (!ALIGN_EPI) { if (wr == 0) PG8_BAR; }
    PG8_BAR;
    if constexpr (Epi::AFTER_DRAIN) { E.fused(acc, cur, wr, wc, fr, fq, lds, wid, lane); S.done(cur); }
#undef PG8_SA
#undef PG8_SB
#undef PG8_STAGE
#undef PG8_LDA
#undef PG8_LDB
#undef PG8_MMA
#undef PG8_WAIT_V
#undef PG8_WAIT_L
#undef PG8_BAR
#undef PG8_SCHED
}
}

__device__ __forceinline__ u32x4 pack8(const f32x4 a, const f32x4 b) { u32x4 w; w.x = cvt_pk_bf16(a[0], a[1]); w.y = cvt_pk_bf16(a[2], a[3]); w.z = cvt_pk_bf16(b[0], b[1]); w.w = cvt_pk_bf16(b[2], b[3]); return w; }
__device__ __forceinline__ void unpack8(const u32x4 w, f32x4& a, f32x4& b) {
    a[0] = __uint_as_float(w.x << 16); a[1] = __uint_as_float(w.x & 0xffff0000u); a[2] = __uint_as_float(w.y << 16); a[3] = __uint_as_float(w.y & 0xffff0000u);
    b[0] = __uint_as_float(w.z << 16); b[1] = __uint_as_float(w.z & 0xffff0000u); b[2] = __uint_as_float(w.w << 16); b[3] = __uint_as_float(w.w & 0xffff0000u); }
__device__ __forceinline__ f32x4 silu_mul(const f32x4 g, const f32x4 u) { f32x4 r;
#pragma unroll
    for (int e = 0; e < 4; ++e) r[e] = g[e] * sigmoid_f(g[e]) * u[e];
    return r; }

__device__ __forceinline__ void row_stats4(const float* st, int rowb, int fq, float (&mu)[4], float (&rs)[4]) {
    f32x4 a[4], b[4];
#pragma unroll
    for (int m = 0; m < 4; ++m) { const f32x4* p = (const f32x4*)(st + (size_t)(rowb + m * 16) * 32 + fq * 8); a[m] = p[0]; b[m] = p[1]; }
#pragma unroll
    for (int m = 0; m < 4; ++m) { float s1 = (a[m][0] + a[m][2]) + (b[m][0] + b[m][2]), s2 = (a[m][1] + a[m][3]) + (b[m][1] + b[m][3]);
        s1 = xsum32(xsum16(s1)); s2 = xsum32(xsum16(s2));
        const float mm = s1 * (1.0f / 1024.0f); mu[m] = mm; rs[m] = rsqrtf(fmaxf(s2 * (1.0f / 1024.0f) - mm * mm, 0.f) + LN_EPS_); }
    asm volatile("" ::: "memory");
}
struct EpiSwiglu {
    static constexpr bool PERM = true, AFTER_DRAIN = false, MIDK = false;
    bf16_t* H; const float* st; const float* gW; const float* bW;
    __device__ __forceinline__ void operator()(const f32x4 (&acc)[2][2][4][2], const pg8::Unit& u, int wr, int wc, int fr, int fq) const {
        const int row0 = u.pm * 256 + wr * 64 + fr, cl = wc * 32 + fq * 8, cB0 = u.pn * 256 + cl;
        f32x4 g0[2], g1[2], b0[2], b1[2];
#pragma unroll
        for (int n = 0; n < 2; ++n) { g0[n] = *(const f32x4*)(gW + cB0 + 4 * n); g1[n] = *(const f32x4*)(gW + cB0 + 128 + 4 * n); b0[n] = *(const f32x4*)(bW + cB0 + 4 * n); b1[n] = *(const f32x4*)(bW + cB0 + 128 + 4 * n); }
        float muA[4], rsA[4], muB[4], rsB[4]; row_stats4(st, row0, fq, muA, rsA); row_stats4(st, row0 + 128, fq, muB, rsB);
        u32x4 ow[2][4];
#pragma unroll
        for (int ai = 0; ai < 2; ++ai)
#pragma unroll
            for (int m = 0; m < 4; ++m) { const float mu = ai ? muB[m] : muA[m], rs = ai ? rsB[m] : rsA[m]; f32x4 h[2];
#pragma unroll
                for (int n = 0; n < 2; ++n) { const f32x4 zg = (acc[ai][0][m][n] - g0[n] * mu) * rs + b0[n], zu = (acc[ai][1][m][n] - g1[n] * mu) * rs + b1[n]; h[n] = silu_mul(zg, zu); }
                ow[ai][m] = pack8(h[0], h[1]); }
        asm volatile("" ::: "memory");
#pragma unroll
        for (int ai = 0; ai < 2; ++ai)
#pragma unroll
            for (int m = 0; m < 4; ++m) *(u32x4*)(H + blk_off(row0 + ai * 128 + m * 16, u.pn * 128 + cl, FF_)) = ow[ai][m];
    }
};
struct EpiResid {
    static constexpr bool PERM = true, AFTER_DRAIN = false, MIDK = false;
    const float* Yin; float* Y; bf16_t* Yb; const float* stp; float* stn; const float* g; const float* b; float sc;
    __device__ __forceinline__ void operator()(const f32x4 (&acc)[2][2][4][2], const pg8::Unit& u, int wr, int wc, int fr, int fq) const {
        const int row0 = u.pm * 256 + wr * 64 + fr, col0 = u.pn * 256 + wc * 32 + fq * 8;
#pragma unroll
        for (int ai = 0; ai < 2; ++ai) { float mu4[4], rs4[4]; row_stats4(stp, row0 + ai * 128, fq, mu4, rs4);
#pragma unroll
            for (int m = 0; m < 4; ++m) { const int row = row0 + ai * 128 + m * 16; const float mu = mu4[m], rs = rs4[m];
                f32x4 yv[2][2], gq[2][2], bq_[2][2];
#pragma unroll
                for (int bj = 0; bj < 2; ++bj)
#pragma unroll
                    for (int n = 0; n < 2; ++n) { yv[bj][n] = *(const f32x4*)(Yin + (size_t)row * D_ + col0 + bj * 128 + 4 * n); gq[bj][n] = *(const f32x4*)(g + col0 + bj * 128 + 4 * n); bq_[bj][n] = *(const f32x4*)(b + col0 + bj * 128 + 4 * n); }
                asm volatile("" ::: "memory");
                float s1 = 0.f, s2 = 0.f;
#pragma unroll
                for (int bj = 0; bj < 2; ++bj) { float* yp = Y + (size_t)row * D_ + col0 + bj * 128; f32x4 v[2];
#pragma unroll
                    for (int n = 0; n < 2; ++n) { v[n] = (((yv[bj][n] - mu) * rs) * gq[bj][n] + bq_[bj][n]) * ALPHA_ + acc[ai][bj][m][n] * sc;
                        *(f32x4*)(yp + 4 * n) = v[n]; s1 += (v[n][0] + v[n][1]) + (v[n][2] + v[n][3]); s2 += (v[n][0] * v[n][0] + v[n][1] * v[n][1]) + (v[n][2] * v[n][2] + v[n][3] * v[n][3]); }
                    *(u32x4*)(Yb + blk_off(row, col0 + bj * 128, D_)) = pack8(v[0], v[1]); }
                s1 = xsum32(xsum16(s1)); s2 = xsum32(xsum16(s2));
                if (fq == 0) *(f32x2*)(stn + (size_t)row * 32 + (u.pn * 4 + wc) * 2) = (f32x2){s1, s2}; asm volatile("" ::: "memory"); } }
    }
};
struct EpiProj {
    static constexpr bool PERM = true, AFTER_DRAIN = false, MIDK = false;
    bf16_t* P; const float* st; const float* gW; const float* bW; const float* cosT; const float* sinT;
    __device__ __forceinline__ void operator()(const f32x4 (&acc)[2][2][4][2], const pg8::Unit& u, int wr, int wc, int fr, int fq) const {
        const int row0 = u.pm * 256 + wr * 64 + fr, cl = wc * 32 + fq * 8, cB0 = u.pn * 256 + cl;
        const bool rope = u.pn < 11, qsc = (u.pn < 2) || (u.pn >= 4 && u.pn < 8);
#pragma unroll
        for (int ai = 0; ai < 2; ++ai) { float mu4[4], rs4[4]; row_stats4(st, row0 + ai * 128, fq, mu4, rs4);
#pragma unroll
          for (int mh = 0; mh < 2; ++mh) { f32x4 cv[2][2], sv[2][2];
            if (rope) {
#pragma unroll
                for (int mm = 0; mm < 2; ++mm)
#pragma unroll
                    for (int n = 0; n < 2; ++n) { const size_t ro = (size_t)(row0 + ai * 128 + (2 * mh + mm) * 16) * 32 + fq * 8 + 4 * n; cv[mm][n] = *(const f32x4*)(cosT + ro); sv[mm][n] = *(const f32x4*)(sinT + ro); } }
#pragma unroll
            for (int mm = 0; mm < 2; ++mm) { const int m = 2 * mh + mm; const int row = row0 + ai * 128 + m * 16; const float mu = mu4[m], rs = rs4[m];
                f32x4 g0[2], g1[2], b0[2], b1[2];
#pragma unroll
                for (int n = 0; n < 2; ++n) { g0[n] = *(const f32x4*)(gW + cB0 + 4 * n); g1[n] = *(const f32x4*)(gW + cB0 + 128 + 4 * n); b0[n] = *(const f32x4*)(bW + cB0 + 4 * n); b1[n] = *(const f32x4*)(bW + cB0 + 128 + 4 * n); }
                f32x4 t1[2], t2[2];
#pragma unroll
                for (int n = 0; n < 2; ++n) { t1[n] = (acc[ai][0][m][n] - g0[n] * mu) * rs + b0[n]; t2[n] = (acc[ai][1][m][n] - g1[n] * mu) * rs + b1[n]; }
                bf16_t* pr = P + (size_t)row * NP_ + u.pn * 256;
                if (rope) { f32x4 o1[2], o2[2];
#pragma unroll
                    for (int n = 0; n < 2; ++n) { const f32x4 c = cv[mm][n], s = sv[mm][n];
                        o1[n] = t1[n] * c - t2[n] * s; o2[n] = t2[n] * c + t1[n] * s; }
                    if (qsc) { o1[0] *= SC2_; o1[1] *= SC2_; o2[0] *= SC2_; o2[1] *= SC2_; }
                    *(u32x4*)(pr + wc * 64 + fq * 8) = pack8(o1[0], o1[1]); *(u32x4*)(pr + wc * 64 + 32 + fq * 8) = pack8(o2[0], o2[1]);
                } else { *(u32x4*)(pr + cl) = pack8(t1[0], t1[1]); *(u32x4*)(pr + 128 + cl) = pack8(t2[0], t2[1]); } asm volatile("" ::: "memory"); } } }
    }
};
struct EpiGate {
    static constexpr bool PERM = true, AFTER_DRAIN = false, MIDK = false;
    bf16_t* G; const float* st; const float* gW; const float* bW;
    __device__ __forceinline__ void operator()(const f32x4 (&acc)[2][2][4][2], const pg8::Unit& u, int wr, int wc, int fr, int fq) const {
        const int row0 = u.pm * 256 + wr * 64 + fr, cl = wc * 32 + fq * 8, cB0 = u.pn * 256 + cl;
        f32x4 gg[2][2], bb[2][2];
#pragma unroll
        for (int bj = 0; bj < 2; ++bj)
#pragma unroll
            for (int n = 0; n < 2; ++n) { gg[bj][n] = *(const f32x4*)(gW + cB0 + bj * 128 + 4 * n); bb[bj][n] = *(const f32x4*)(bW + cB0 + bj * 128 + 4 * n); }
        float muA[4], rsA[4], muB[4], rsB[4]; row_stats4(st, row0, fq, muA, rsA); row_stats4(st, row0 + 128, fq, muB, rsB);
#pragma unroll
        for (int ai = 0; ai < 2; ++ai)
#pragma unroll
            for (int m = 0; m < 4; ++m) { const float mu = ai ? muB[m] : muA[m], rs = ai ? rsB[m] : rsA[m];
#pragma unroll
                for (int bj = 0; bj < 2; ++bj) { f32x4 z[2];
#pragma unroll
                    for (int n = 0; n < 2; ++n) { z[n] = (acc[ai][bj][m][n] - gg[bj][n] * mu) * rs + bb[bj][n];
#pragma unroll
                        for (int e = 0; e < 4; ++e) z[n][e] = sigmoid_f(z[n][e]); }
                    *(u32x4*)(G + (size_t)(row0 + ai * 128 + m * 16) * NG_ + cB0 + bj * 128) = pack8(z[0], z[1]); }
                asm volatile("" ::: "memory"); }
    }
};
struct EpiBranch {
    static constexpr bool PERM = true, AFTER_DRAIN = false, MIDK = true;
    const bf16_t* G; bf16_t* Mg;
    __device__ __forceinline__ void mid(f32x4 (&acc)[2][2][4][2], const pg8::Unit& u, int t, int wr, int wc, int fr, int fq) const {
        const int brd = (t >> 3) - 1;
        int fr_ = fr; asm volatile("" : "+v"(fr_));
        const int row0 = u.pm * 256 + wr * 64 + fr_, col0 = u.pn * 256 + wc * 32 + fq * 8;
#pragma unroll
        for (int ai = 0; ai < 2; ++ai)
#pragma unroll
            for (int m = 0; m < 4; ++m) { const bf16_t* gp = G + (size_t)(row0 + ai * 128 + m * 16) * NG_ + brd * 1024 + col0;
                u32x4 xw[2], yw[2];
#pragma unroll
                for (int bj = 0; bj < 2; ++bj) { xw[bj] = *(const u32x4*)(gp + bj * 128); yw[bj] = *(const u32x4*)(gp + 1024 + bj * 128); }
#pragma unroll
                for (int bj = 0; bj < 2; ++bj) { f32x4 xa, xb, ya, yb; unpack8(xw[bj], xa, xb); unpack8(yw[bj], ya, yb);
#pragma unroll
                    for (int e = 0; e < 4; ++e) { acc[ai][bj][m][0][e] *= xa[e] * fast_rcp(fmaxf(ya[e], 1e-30f)); acc[ai][bj][m][1][e] *= xb[e] * fast_rcp(fmaxf(yb[e], 1e-30f)); } }
                asm volatile("" ::: "memory"); }
    }
    __device__ __forceinline__ void operator()(const f32x4 (&acc)[2][2][4][2], const pg8::Unit& u, int wr, int wc, int fr, int fq) const {
        const int row0 = u.pm * 256 + wr * 64 + fr, col0 = u.pn * 256 + wc * 32 + fq * 8;
        u32x4 gw[2][4][2];
#pragma unroll
        for (int ai = 0; ai < 2; ++ai)
#pragma unroll
            for (int m = 0; m < 4; ++m)
#pragma unroll
                for (int bj = 0; bj < 2; ++bj) gw[ai][m][bj] = *(const u32x4*)(G + (size_t)(row0 + ai * 128 + m * 16) * NG_ + 2048 + col0 + bj * 128);
        asm volatile("" ::: "memory");
#pragma unroll
        for (int ai = 0; ai < 2; ++ai)
#pragma unroll
            for (int m = 0; m < 4; ++m)
#pragma unroll
                for (int bj = 0; bj < 2; ++bj) { f32x4 ga, gb; unpack8(gw[ai][m][bj], ga, gb);
                    *(u32x4*)(Mg + blk_off(row0 + ai * 128 + m * 16, col0 + bj * 128, D_)) = pack8(ga * acc[ai][bj][m][0], gb * acc[ai][bj][m][1]); }
    }
};

#ifndef DSA1_REPS
#define DSA1_REPS 1
#endif
#ifndef DSA3_REPS
#define DSA3_REPS 1
#endif
#define MFMA16(a, b, c) __builtin_amdgcn_mfma_f32_16x16x32_bf16((a), (b), (c), 0, 0, 0)
typedef short v4i16_t __attribute__((ext_vector_type(4)));
__device__ __forceinline__ s16x4 tr_read(LAS unsigned char* p) { return __builtin_bit_cast(s16x4, __builtin_amdgcn_ds_read_tr16_b64_v4i16((LAS v4i16_t*)p)); }
struct KVRegs { bf16x8 ka[2], kb[2]; u32x4 v[4]; };
__device__ __forceinline__ void kv_load(KVRegs& r, const bf16_t* kbase, size_t kst, const bf16_t* vbase, int s, int lane) {
    const int li = lane & 15, g4 = lane >> 4;
    const bf16_t* k0 = kbase + (size_t)(32 * s + li) * kst + 8 * g4;
    r.ka[0] = *(const bf16x8*)k0; r.ka[1] = *(const bf16x8*)(k0 + 32);
    const bf16_t* k1 = k0 + 16 * kst;
    r.kb[0] = *(const bf16x8*)k1; r.kb[1] = *(const bf16x8*)(k1 + 32);
    const bf16_t* vp = vbase + (size_t)(32 * s + (lane >> 1)) * kst + (lane & 1) * 32;
#pragma unroll
    for (int i = 0; i < 4; ++i) r.v[i] = *(const u32x4*)(vp + 8 * i);
}
struct BandMask { int k0, iq, W; __device__ __forceinline__ float operator()(int ko, float s) const { return ((unsigned)(iq - (k0 + ko)) <= (unsigned)W) ? s : -INFINITY; } };
struct SelMask { unsigned w; __device__ __forceinline__ float operator()(int ko, float s) const { const int mk = (int)(w << (31 - ko)) >> 31; return __uint_as_float((__float_as_uint(s) & (unsigned)mk) | (0xff800000u & ~(unsigned)mk)); } };
template <class MaskF>
__device__ __forceinline__ void attn_step(const KVRegs& r, const bf16x8 (&bq)[2], LAS unsigned char* vl, int lane, const MaskF mask, float& m, float& l, f32x4 (&o)[4]) {
    const int g4 = lane >> 4;
    { LAS unsigned char* wp = vl + (lane >> 1) * 128 + (lane & 1) * 64;
#pragma unroll
      for (int i = 0; i < 4; ++i) *(LAS u32x4*)(wp + 16 * i) = r.v[i]; }
    f32x4 sa = (f32x4){0.f, 0.f, 0.f, 0.f}, sb = (f32x4){0.f, 0.f, 0.f, 0.f};
    sa = MFMA16(r.ka[0], bq[0], sa); sa = MFMA16(r.ka[1], bq[1], sa);
    sb = MFMA16(r.kb[0], bq[0], sb); sb = MFMA16(r.kb[1], bq[1], sb);
    float x[8];
#pragma unroll
    for (int e = 0; e < 4; ++e) { x[e] = mask(4 * g4 + e, sa[e]); x[4 + e] = mask(16 + 4 * g4 + e, sb[e]); }
    float tm = fmaxf(fmaxf(fmaxf(x[0], x[1]), fmaxf(x[2], x[3])), fmaxf(fmaxf(x[4], x[5]), fmaxf(x[6], x[7])));
    tm = xmax32(xmax16(tm));
    const float mn = fmaxf(m, tm);
    if (__ballot(mn > m)) { const float al = fast_exp2(m - mn); l *= al;
#pragma unroll
        for (int db = 0; db < 4; ++db) o[db] = o[db] * al; }
    m = mn;
    float p[8], ps = 0.f;
#pragma unroll
    for (int e = 0; e < 8; ++e) { p[e] = fast_exp2(x[e] - mn); ps += p[e]; }
    l += ps;
    u32x4 pw; pw.x = cvt_pk_bf16(p[0], p[1]); pw.y = cvt_pk_bf16(p[2], p[3]); pw.z = cvt_pk_bf16(p[4], p[5]); pw.w = cvt_pk_bf16(p[6], p[7]);
    const bf16x8 pf = __builtin_bit_cast(bf16x8, pw);
    asm volatile("s_waitcnt lgkmcnt(0)" ::: "memory");
    LAS unsigned char* rd = vl + (4 * g4 + ((lane & 15) >> 2)) * 128 + (lane & 3) * 8;
#pragma unroll
    for (int db = 0; db < 4; ++db) { const s16x4 t0 = tr_read(rd + db * 32), t1 = tr_read(rd + 16 * 128 + db * 32);
        const bf16x8 vf = (bf16x8){t0[0], t0[1], t0[2], t0[3], t1[0], t1[1], t1[2], t1[3]};
        o[db] = MFMA16(vf, pf, o[db]); }
    asm volatile("s_waitcnt lgkmcnt(0)" ::: "memory");
}
__device__ __forceinline__ void attn_store(const f32x4 (&o)[4], float inv, bf16_t* op, int g4) {
#pragma unroll
    for (int db = 0; db < 4; ++db) { u32x2 w; w.x = cvt_pk_bf16(o[db][0] * inv, o[db][1] * inv); w.y = cvt_pk_bf16(o[db][2] * inv, o[db][3] * inv); *(u32x2*)(op + 16 * db + 4 * g4) = w; }
}
struct BandGen { int iq, W; __device__ __forceinline__ BandMask operator()(int s) const { return BandMask{32 * s, iq, W}; } };
struct SelGen { const LAS unsigned char* row; __device__ __forceinline__ SelMask operator()(int s) const { return SelMask{*(const LAS unsigned*)(row + 4 * s)}; } };
template <class Gen>
__device__ __forceinline__ void attn_loop(const bf16_t* kbase, size_t kst, const bf16_t* vbase, int s_lo, int s_hi, const bf16x8 (&bq)[2], LAS unsigned char* vl, int lane, const Gen gen, float& m, float& l, f32x4 (&o)[4]) {
    KVRegs kv[4];
    kv_load(kv[0], kbase, kst, vbase, s_lo, lane);
    if (s_lo + 1 <= s_hi) kv_load(kv[1], kbase, kst, vbase, s_lo + 1, lane);
    if (s_lo + 2 <= s_hi) kv_load(kv[2], kbase, kst, vbase, s_lo + 2, lane);
    for (int s = s_lo; s <= s_hi; s += 4) {
#pragma unroll
        for (int j = 0; j < 4; ++j) {
            if (s + j <= s_hi) {
                if (s + j + 3 <= s_hi) kv_load(kv[(j + 3) & 3], kbase, kst, vbase, s + j + 3, lane);
                attn_step(kv[j], bq, vl, lane, gen(s + j), m, l, o);
            }
        }
    }
}
template <int NQ>
__device__ __forceinline__ void band_step(const KVRegs& r, const bf16x8 (&bq)[NQ][2], LAS unsigned char* vl, int lane, int s, int q0, int W, float (&m)[NQ], float (&l)[NQ], f32x4 (&o)[NQ][4]) {
    const int g4 = lane >> 4, qi = lane & 15;
    { LAS unsigned char* wp = vl + (lane >> 1) * 128 + (lane & 1) * 64;
#pragma unroll
      for (int i = 0; i < 4; ++i) *(LAS u32x4*)(wp + 16 * i) = r.v[i]; }
    asm volatile("s_waitcnt lgkmcnt(0)" ::: "memory");
    bf16x8 vf[4];
    { LAS unsigned char* rd = vl + (4 * g4 + (qi >> 2)) * 128 + (lane & 3) * 8;
#pragma unroll
      for (int db = 0; db < 4; ++db) { const s16x4 t0 = tr_read(rd + db * 32), t1 = tr_read(rd + 16 * 128 + db * 32);
          vf[db] = (bf16x8){t0[0], t0[1], t0[2], t0[3], t1[0], t1[1], t1[2], t1[3]}; } }
#pragma unroll
    for (int g = 0; g < NQ; ++g) {
        const int qlo = q0 + 16 * g;
        if (32 * s <= qlo + 15 && 32 * s + 31 >= qlo - W) {
            f32x4 sa = (f32x4){0.f, 0.f, 0.f, 0.f}, sb = (f32x4){0.f, 0.f, 0.f, 0.f};
            sa = MFMA16(r.ka[0], bq[g][0], sa); sa = MFMA16(r.ka[1], bq[g][1], sa);
            sb = MFMA16(r.kb[0], bq[g][0], sb); sb = MFMA16(r.kb[1], bq[g][1], sb);
            const BandMask mask{32 * s, qlo + qi, W};
            float x[8];
#pragma unroll
            for (int e = 0; e < 4; ++e) { x[e] = mask(4 * g4 + e, sa[e]); x[4 + e] = mask(16 + 4 * g4 + e, sb[e]); }
            float tm = fmaxf(fmaxf(fmaxf(x[0], x[1]), fmaxf(x[2], x[3])), fmaxf(fmaxf(x[4], x[5]), fmaxf(x[6], x[7])));
            tm = xmax32(xmax16(tm));
            const float mn = fmaxf(m[g], tm);
            if (__ballot(mn > m[g])) { const float al = fast_exp2(m[g] - mn); l[g] *= al;
#pragma unroll
                for (int db = 0; db < 4; ++db) o[g][db] = o[g][db] * al; }
            m[g] = mn;
            float pp[8], ps = 0.f;
#pragma unroll
            for (int e = 0; e < 8; ++e) { pp[e] = fast_exp2(x[e] - mn); ps += pp[e]; }
            l[g] += ps;
            u32x4 pw; pw.x = cvt_pk_bf16(pp[0], pp[1]); pw.y = cvt_pk_bf16(pp[2], pp[3]); pw.z = cvt_pk_bf16(pp[4], pp[5]); pw.w = cvt_pk_bf16(pp[6], pp[7]);
            const bf16x8 pf = __builtin_bit_cast(bf16x8, pw);
#pragma unroll
            for (int db = 0; db < 4; ++db) o[g][db] = MFMA16(vf[db], pf, o[g][db]);
        }
    }
}
template <int NQ>
__device__ __forceinline__ void band_unit(int u, const bf16_t* P, bf16_t* OB, bf16_t* ACX, float* LSE, const float* sink, LAS unsigned char* vl, int lane_in) {
    int lane = lane_in; asm volatile("" : "+v"(lane));
    constexpr int UQ = 16 * NQ, TPS = SEQ_ / UQ, UPC = NB_ * 8 * TPS;
    const int cfg = u / UPC, rr = u % UPC, b = rr / (8 * TPS), h = (rr / TPS) & 7, ts = rr % TPS;
    const int d = (cfg == 1) ? 4 : (cfg == 2) ? 16 : 1, tpc = TPS / d, cls = ts / tpc, it = ts % tpc, q0 = UQ * it, W = (cfg == 3) ? 127 : 128;
    const int qcol = (cfg < 3) ? PC_QA + h * 64 : PC_QB + h * 64, kcol = (cfg < 3) ? PC_KA + h * 64 : PC_KB + (h >> 2) * 64, vcol = (cfg < 3) ? PC_VA + h * 64 : PC_VB + (h >> 2) * 64;
    const size_t rowbase = (size_t)b * SEQ_ + cls, kst = (size_t)d * NP_;
    const bf16_t* kbase = P + rowbase * NP_ + kcol; const bf16_t* vbase = P + rowbase * NP_ + vcol;
    const int qi = lane & 15, g4 = lane >> 4;
    bf16x8 bq[NQ][2]; float m[NQ], l[NQ]; f32x4 o[NQ][4];
#pragma unroll
    for (int g = 0; g < NQ; ++g) { const bf16_t* qp = P + (rowbase + (size_t)d * (q0 + 16 * g + qi)) * NP_ + qcol + 8 * g4; bq[g][0] = *(const bf16x8*)qp; bq[g][1] = *(const bf16x8*)(qp + 32);
        m[g] = -1e30f; l[g] = 0.f; if (cfg == 3) { m[g] = sink[h] * 1.4426950408889634f; l[g] = (g4 == 0) ? 1.f : 0.f; }
#pragma unroll
        for (int db = 0; db < 4; ++db) o[g][db] = (f32x4){0.f, 0.f, 0.f, 0.f}; }
    const int s_hi = (q0 + UQ - 1) >> 5, s_lo = (q0 >= 128) ? ((q0 - 128) >> 5) : 0;
    constexpr int RING = (NQ > 2) ? 2 : 3;
    KVRegs kv[RING];
    kv_load(kv[0], kbase, kst, vbase, s_lo, lane);
    if (RING > 2 && s_lo + 1 <= s_hi) kv_load(kv[1], kbase, kst, vbase, s_lo + 1, lane);
    for (int s = s_lo; s <= s_hi; s += RING) {
#pragma unroll
        for (int j = 0; j < RING; ++j) {
            if (s + j <= s_hi) {
                if (s + j + RING - 1 <= s_hi) kv_load(kv[(j + RING - 1) % RING], kbase, kst, vbase, s + j + RING - 1, lane);
                band_step<NQ>(kv[j], bq, vl, lane, s + j, q0, W, m, l, o);
            }
        }
    }
#pragma unroll
    for (int g = 0; g < NQ; ++g) {
        const size_t tq = rowbase + (size_t)d * (q0 + 16 * g + qi);
        float lt = l[g]; lt = xsum32(xsum16(lt));
        bf16_t* op = (cfg == 0) ? OB + tq * NO_ + h * 64 : (cfg == 3) ? OB + tq * NO_ + 512 + h * 64 : ACX + (size_t)(cfg - 1) * T_ * 512 + tq * 512 + h * 64;
        attn_store(o[g], fast_rcp(lt), op, g4);
        if (cfg < 3 && g4 == 0) LSE[(size_t)cfg * T_ * 8 + tq * 8 + h] = m[g] + __log2f(lt);
    }
}
template <class MaskF>
__device__ __forceinline__ void attn_step_lds(const LAS unsigned char* kl, LAS unsigned char* vl, const bf16x8 (&bq)[2], int lane, const MaskF mask, float& m, float& l, f32x4 (&o)[4]) {
    const int g4 = lane >> 4, li = lane & 15;
    const LAS unsigned char* kp = kl + li * 144 + 16 * g4;
    const bf16x8 ka0 = *(const LAS bf16x8*)kp, ka1 = *(const LAS bf16x8*)(kp + 64), kb0 = *(const LAS bf16x8*)(kp + 16 * 144), kb1 = *(const LAS bf16x8*)(kp + 16 * 144 + 64);
    f32x4 sa = (f32x4){0.f, 0.f, 0.f, 0.f}, sb = (f32x4){0.f, 0.f, 0.f, 0.f};
    sa = MFMA16(ka0, bq[0], sa); sa = MFMA16(ka1, bq[1], sa);
    sb = MFMA16(kb0, bq[0], sb); sb = MFMA16(kb1, bq[1], sb);
    LAS unsigned char* rd = vl + (4 * g4 + (li >> 2)) * 128 + (lane & 3) * 8;
    s16x4 t0[4], t1[4];
#pragma unroll
    for (int db = 0; db < 4; ++db) { t0[db] = tr_read(rd + db * 32); t1[db] = tr_read(rd + 16 * 128 + db * 32); }
    float x[8];
#pragma unroll
    for (int e = 0; e < 4; ++e) { x[e] = mask(4 * g4 + e, sa[e]); x[4 + e] = mask(16 + 4 * g4 + e, sb[e]); }
    float tm = fmaxf(fmaxf(fmaxf(x[0], x[1]), fmaxf(x[2], x[3])), fmaxf(fmaxf(x[4], x[5]), fmaxf(x[6], x[7])));
    tm = xmax32(xmax16(tm));
    const float mn = fmaxf(m, tm);
    if (__ballot(mn > m)) { const float al = fast_exp2(m - mn); l *= al;
#pragma unroll
        for (int db = 0; db < 4; ++db) o[db] = o[db] * al; }
    m = mn;
    float p[8], ps = 0.f;
#pragma unroll
    for (int e = 0; e < 8; ++e) { p[e] = fast_exp2(x[e] - mn); ps += p[e]; }
    l += ps;
    u32x4 pw; pw.x = cvt_pk_bf16(p[0], p[1]); pw.y = cvt_pk_bf16(p[2], p[3]); pw.z = cvt_pk_bf16(p[4], p[5]); pw.w = cvt_pk_bf16(p[6], p[7]);
    const bf16x8 pf = __builtin_bit_cast(bf16x8, pw);
#pragma unroll
    for (int db = 0; db < 4; ++db) { const bf16x8 vf = (bf16x8){t0[db][0], t0[db][1], t0[db][2], t0[db][3], t1[db][0], t1[db][1], t1[db][2], t1[db][3]};
        o[db] = MFMA16(vf, pf, o[db]); }
}
constexpr int C_SCW = 4112, C_IDX = 16 * C_SCW, C_CNT = C_IDX + 16 * 512, C_VT = C_CNT + 64, C_VST = 0, C_LDS_END = C_VT + 8 * 4096;
__device__ __forceinline__ unsigned f16key(unsigned h) { return (h & 0x8000u) ? (~h & 0xffffu) : (h | 0x8000u); }
__device__ __forceinline__ unsigned wave_sum_u32(unsigned c) {
    c += (unsigned)__builtin_amdgcn_update_dpp(0, (int)c, 0x128, 0xf, 0xf, false);
    c += (unsigned)__builtin_amdgcn_update_dpp(0, (int)c, 0x124, 0xf, 0xf, false);
    c += (unsigned)__builtin_amdgcn_update_dpp(0, (int)c, 0x122, 0xf, 0xf, false);
    c += (unsigned)__builtin_amdgcn_update_dpp(0, (int)c, 0x121, 0xf, 0xf, false);
    { const auto r = __builtin_amdgcn_permlane16_swap(c, c, false, false); c = r[0] + r[1]; }
    { const auto r = __builtin_amdgcn_permlane32_swap(c, c, false, false); c = r[0] + r[1]; }
    return c;
}
template <int NJ>
__device__ __forceinline__ void dsa_select(LAS unsigned char* lds, int qs, int t, int lane) {
    unsigned v[NJ];
#pragma unroll
    for (int j = 0; j < NJ; ++j) { const int key = 64 * j + lane; const unsigned raw = *(const LAS unsigned short*)(lds + qs * C_SCW + key * 2); v[j] = (key <= t) ? f16key(raw) : 0u; }
    unsigned theta = 1u; int need = t + 1;
    if (t + 1 > 256) {
        need = 256; theta = 0u;
        for (int bit = 15; bit >= 0; --bit) { const unsigned tr = theta | (1u << bit); unsigned c = 0u;
#pragma unroll
            for (int j = 0; j < NJ; ++j) c += (v[j] >= tr) ? 1u : 0u;
            c = wave_sum_u32(c);
            theta = (c >= 256u) ? tr : theta; }
        theta = (unsigned)__builtin_amdgcn_readfirstlane((int)theta);
    }
    int cgt = 0;
#pragma unroll
    for (int j = 0; j < NJ; ++j) cgt += __popcll(__ballot(v[j] > theta));
    const int rem = need - cgt; int taken = 0, base = 0;
    LAS unsigned short* il = (LAS unsigned short*)(lds + C_IDX + qs * 512);
#pragma unroll
    for (int j = 0; j < NJ; ++j) {
        const bool eq = (v[j] == theta);
        const unsigned long long tmask = __ballot(eq);
        const int rank = (int)__builtin_amdgcn_mbcnt_hi((unsigned)(tmask >> 32), __builtin_amdgcn_mbcnt_lo((unsigned)tmask, 0u)) + taken;
        const bool sel = (v[j] > theta) || (eq && rank < rem);
        const unsigned long long smask = __ballot(sel);
        taken += __popcll(tmask);
        const int pos = base + (int)__builtin_amdgcn_mbcnt_hi((unsigned)(smask >> 32), __builtin_amdgcn_mbcnt_lo((unsigned)smask, 0u));
        if (sel) il[pos] = (unsigned short)(64 * j + lane);
        base += __popcll(smask);
    }
#pragma unroll
    for (int i = 0; i < 4; ++i) { const int pos = base + lane + 64 * i; if (pos < 256) il[pos] = 0; }
    if (lane == 0) *(LAS int*)(lds + C_CNT + qs * 4) = base;
}
struct CountMask { int s32, cnt; __device__ __forceinline__ float operator()(int ko, float s) const { return (s32 + ko < cnt) ? s : -INFINITY; } };
__device__ __forceinline__ void kv_gather(KVRegs& r, const bf16_t* Pb, const LAS unsigned short* il, int s, int lane) {
    const int li = lane & 15, g4 = lane >> 4;
    const unsigned ra = il[32 * s + li], rb = il[32 * s + 16 + li], rv = il[32 * s + (lane >> 1)];
    const bf16_t* k0 = Pb + (size_t)ra * NP_ + PC_KC + 8 * g4; const bf16_t* k1 = Pb + (size_t)rb * NP_ + PC_KC + 8 * g4;
    r.ka[0] = *(const bf16x8*)k0; r.ka[1] = *(const bf16x8*)(k0 + 32); r.kb[0] = *(const bf16x8*)k1; r.kb[1] = *(const bf16x8*)(k1 + 32);
    const bf16_t* vp = Pb + (size_t)rv * NP_ + PC_VC + (lane & 1) * 32;
#pragma unroll
    for (int i = 0; i < 4; ++i) r.v[i] = *(const u32x4*)(vp + 8 * i);
}
__device__ __forceinline__ void dsa_unit(int b, int blk, const bf16_t* P, bf16_t* OB, LAS unsigned char* lds, int wave, int tid_in) {
    int tid = tid_in; asm volatile("" : "+v"(tid));
    const int lane = tid & 63;
    const int t0 = blk * 16, nk = t0 + 16; const size_t tok0 = (size_t)b * SEQ_;
    const int qi = lane & 15, g4 = lane >> 4;
    const bf16_t* qrow = P + (tok0 + t0 + qi) * NP_;
    {
        bf16x8 bqi[8][2]; float w[8];
#pragma unroll
        for (int h = 0; h < 8; ++h) { bqi[h][0] = *(const bf16x8*)(qrow + PC_QI + h * 64 + 8 * g4); bqi[h][1] = *(const bf16x8*)(qrow + PC_QI + h * 64 + 32 + 8 * g4); }
        { const u32x4 ww = *(const u32x4*)(qrow + PC_WI); f32x4 wa, wb; unpack8(ww, wa, wb);
#pragma unroll
          for (int e = 0; e < 4; ++e) { w[e] = wa[e]; w[4 + e] = wb[e]; } }
        const int ntile = nk >> 4;
        const bf16_t* kp0 = P + (tok0 + qi) * NP_ + PC_KI + 8 * g4;
        bf16x8 kf[6][2];
#pragma unroll
        for (int i = 0; i < 5; ++i) if (wave + 8 * i < ntile) { const bf16_t* kp = kp0 + (size_t)(16 * (wave + 8 * i)) * NP_; kf[i][0] = *(const bf16x8*)kp; kf[i][1] = *(const bf16x8*)(kp + 32); }
        for (int kt = wave; kt < ntile; kt += 48) {
#pragma unroll
            for (int j = 0; j < 6; ++j) {
                const int kc = kt + 8 * j;
                if (kc < ntile) {
                    if (kc + 40 < ntile) { const bf16_t* kp = kp0 + (size_t)(16 * (kc + 40)) * NP_; kf[(j + 5) % 6][0] = *(const bf16x8*)kp; kf[(j + 5) % 6][1] = *(const bf16x8*)(kp + 32); }
                    f32x4 sc = (f32x4){0.f, 0.f, 0.f, 0.f};
#pragma unroll
                    for (int h = 0; h < 8; ++h) { f32x4 s = (f32x4){0.f, 0.f, 0.f, 0.f}; s = MFMA16(kf[j][0], bqi[h][0], s); s = MFMA16(kf[j][1], bqi[h][1], s);
#pragma unroll
                        for (int e = 0; e < 4; ++e) sc[e] = fmaf(w[h], fmaxf(s[e], 0.f), sc[e]); }
                    u32x2 o2;
                    { const _Float16 h0 = (_Float16)sc[0], h1 = (_Float16)sc[1], h2 = (_Float16)sc[2], h3 = (_Float16)sc[3];
                      o2.x = (unsigned)__builtin_bit_cast(unsigned short, h0) | ((unsigned)__builtin_bit_cast(unsigned short, h1) << 16);
                      o2.y = (unsigned)__builtin_bit_cast(unsigned short, h2) | ((unsigned)__builtin_bit_cast(unsigned short, h3) << 16); }
                    *(LAS u32x2*)(lds + qi * C_SCW + (16 * kc + 4 * g4) * 2) = o2;
                }
            }
        }
    }
    __syncthreads();
    {
        const int nj = (nk + 63) >> 6;
        for (int qq = 0; qq < 2; ++qq) {
            const int qs = wave * 2 + qq, t = t0 + qs;
            if (nj <= 8) dsa_select<8>(lds, qs, t, lane); else if (nj <= 16) dsa_select<16>(lds, qs, t, lane); else if (nj <= 24) dsa_select<24>(lds, qs, t, lane); else dsa_select<32>(lds, qs, t, lane);
        }
    }
    __syncthreads();
    {
        const bf16_t* Pb = P + tok0 * NP_;
        LAS unsigned char* vl = lds + C_VT + wave * 4096;
        const int col = lane & 15;
        for (int qq = 0; qq < 2; ++qq) {
            const int qs = wave * 2 + qq;
            const LAS unsigned short* il = (const LAS unsigned short*)(lds + C_IDX + qs * 512);
            const int cnt = *(const LAS int*)(lds + C_CNT + qs * 4);
            bf16x8 bq[2];
            { const bf16_t* qp = P + (tok0 + t0 + qs) * NP_ + PC_QC + (col & 7) * 64 + 8 * g4; bq[0] = *(const bf16x8*)qp; bq[1] = *(const bf16x8*)(qp + 32);
              if (col >= 8) { bq[0] = (bf16x8){0, 0, 0, 0, 0, 0, 0, 0}; bq[1] = bq[0]; } }
            float m = -1e30f, l = 0.f; f32x4 o[4];
#pragma unroll
            for (int db = 0; db < 4; ++db) o[db] = (f32x4){0.f, 0.f, 0.f, 0.f};
            const int s_hi = ((cnt + 31) >> 5) - 1;
            KVRegs kv[2];
            kv_gather(kv[0], Pb, il, 0, lane);
            for (int s = 0; s <= s_hi; s += 2) {
#pragma unroll
                for (int j = 0; j < 2; ++j) {
                    if (s + j <= s_hi) {
                        if (s + j + 1 <= s_hi) kv_gather(kv[(j + 1) % 2], Pb, il, s + j + 1, lane);
                        attn_step(kv[j], bq, vl, lane, CountMask{32 * (s + j), cnt}, m, l, o);
                    }
                }
            }
            float lt = l; lt = xsum32(xsum16(lt));
            if (col < 8) attn_store(o, fast_rcp(lt), OB + (tok0 + t0 + qs) * NO_ + 1024 + col * 64, g4);
        }
    }
    __syncthreads();
}

__device__ __forceinline__ void prep_load(f32x4 (&r)[8], const float* W, int N_src, int k0, int src_col, bool cv, int lane) {
    const float* p = W + (size_t)(k0 + (lane >> 3)) * N_src + src_col + 4 * (lane & 7);
#pragma unroll
    for (int i = 0; i < 8; ++i) r[i] = cv ? *(const f32x4*)(p + (size_t)(8 * i) * N_src) : (f32x4){0.f, 0.f, 0.f, 0.f};
}
__device__ __forceinline__ void prep_chunk(const f32x4 (&r)[8], int k0, int ldd, const float* g, const float* b, bf16_t* dst, LAS float* scr, int lane, f32x4& sg, f32x4& sb) {
    const int c4 = lane & 7, r8 = lane >> 3;
#pragma unroll
    for (int i = 0; i < 8; ++i) { const int row = r8 + 8 * i; const float gv = g ? g[k0 + row] : 1.f, bv = b ? b[k0 + row] : 0.f; f32x4 wr;
#pragma unroll
        for (int e = 0; e < 4; ++e) { wr[e] = bf2f(f2bf(r[i][e] * gv)); scr[row * 33 + 4 * c4 + e] = wr[e]; }
        sg += wr; sb += r[i] * bv; }
    asm volatile("s_waitcnt lgkmcnt(0)" ::: "memory");
    const int c = lane & 7;
#pragma unroll
    for (int j = 0; j < 4; ++j) { const int nn = (lane >> 3) + 8 * j; const LAS float* s = scr + (8 * c) * 33 + nn;
        u32x4 o; o.x = (f2bf(s[0]) | (f2bf(s[33]) << 16)); o.y = (f2bf(s[66]) | (f2bf(s[99]) << 16)); o.z = (f2bf(s[132]) | (f2bf(s[165]) << 16)); o.w = (f2bf(s[198]) | (f2bf(s[231]) << 16));
        *(u32x4*)(dst + (size_t)nn * ldd + k0 + 8 * c) = o; }
    asm volatile("s_waitcnt lgkmcnt(0)" ::: "memory");
}
__device__ __forceinline__ void prep_item(const float* W, int N_src, int ldd, int kbeg, int kend, int src_col, int nvalid, const float* g, const float* b, bf16_t* dst, float* gWo, float* bWo, LAS float* scr, int lane_in) {
    int lane = lane_in; asm volatile("" : "+v"(lane));
    const bool cv = 4 * (lane & 7) < nvalid;
    f32x4 sg = (f32x4){0.f, 0.f, 0.f, 0.f}, sb = (f32x4){0.f, 0.f, 0.f, 0.f};
    f32x4 ra[8], rb[8];
    prep_load(ra, W, N_src, kbeg, src_col, cv, lane);
    for (int k0 = kbeg; k0 < kend; k0 += 128) {
        if (k0 + 64 < kend) prep_load(rb, W, N_src, k0 + 64, src_col, cv, lane);
        prep_chunk(ra, k0, ldd, g, b, dst, scr, lane, sg, sb);
        if (k0 + 64 < kend) {
            if (k0 + 128 < kend) prep_load(ra, W, N_src, k0 + 128, src_col, cv, lane);
            prep_chunk(rb, k0 + 64, ldd, g, b, dst, scr, lane, sg, sb);
        }
    }
    if (gWo) {
#pragma unroll
        for (int e = 0; e < 4; ++e) { sg[e] += __shfl_xor(sg[e], 8); sg[e] += __shfl_xor(sg[e], 16); sg[e] += __shfl_xor(sg[e], 32); sb[e] += __shfl_xor(sb[e], 8); sb[e] += __shfl_xor(sb[e], 16); sb[e] += __shfl_xor(sb[e], 32); }
        if (lane < 8) { *(f32x4*)(gWo + 4 * lane) = sg; *(f32x4*)(bWo + 4 * lane) = sb; }
    }
}
__device__ __forceinline__ int proj_src(int G, int& nvalid) {
    const int pn = G >> 3, gi = G & 7; nvalid = 32;
    if (pn < 11) { const int bj = gi >> 2, wc = gi & 3; int hb;
        if (pn < 2) hb = SC_QA + (4 * pn + wc) * 64; else if (pn < 4) hb = SC_KA + (4 * (pn - 2) + wc) * 64; else if (pn < 6) hb = SC_QB + (4 * (pn - 4) + wc) * 64;
        else if (pn < 8) hb = SC_QC + (4 * (pn - 6) + wc) * 64; else if (pn < 10) hb = SC_QI + (4 * (pn - 8) + wc) * 64;
        else hb = (wc == 0) ? SC_KB : (wc == 1) ? SC_KB + 64 : (wc == 2) ? SC_KC : SC_KI;
        return hb + 32 * bj; }
    if (pn < 13) return SC_VA + (pn - 11) * 256 + 32 * gi;
    if (gi < 4) return SC_VB + 32 * gi;
    if (gi < 6) return SC_VC + 32 * (gi - 4);
    if (gi == 6) { nvalid = 8; return SC_WI; }
    nvalid = 0; return 0;
}
constexpr int PREP_ITEMS = 176 + 128 + 112 + 96 + 96 + 32 + 176 + 128;
struct Ptrs {
    const float *x, *w_in, *sink, *w_out, *f1i, *f1o, *f2i, *f2o, *lng, *lnb; const int* pos;
    float *Y, *stats, *cosT, *sinT, *ones, *zeros, *aux, *LSE; bf16_t *Yb, *Wb, *BIG, *OB, *ACX;
};
__device__ __forceinline__ void prep_layer(const Ptrs& p, const float* const* inp, int l, LAS unsigned char* lds, int gw, int ngw, int wave, int lane) {
    LAS float* scr = (LAS float*)(lds + wave * 8448);
    const float* g_prev = (l == 0) ? nullptr : p.lng + (size_t)((l - 1) * 3 + 2) * D_; const float* b_prev = (l == 0) ? nullptr : p.lnb + (size_t)((l - 1) * 3 + 2) * D_;
    const float* g0 = p.lng + (size_t)(l * 3 + 0) * D_; const float* b0 = p.lnb + (size_t)(l * 3 + 0) * D_;
    const float* g1 = p.lng + (size_t)(l * 3 + 1) * D_; const float* b1 = p.lnb + (size_t)(l * 3 + 1) * D_;
    for (int it = gw; it < PREP_ITEMS; it += ngw) {
        int r = it;
        const float* W; int N_src, K, kbeg = 0, kend, src, nv = 32; const float* g = nullptr; const float* b = nullptr; bf16_t* dst; float* gWo = nullptr; float* bWo = nullptr;
        if (r < 176) { const int j = r >> 3, gi = r & 7; src = (gi < 4) ? 128 * j + 32 * gi : FF_ + 128 * j + 32 * (gi - 4);
            W = p.f1i + (size_t)l * D_ * 2 * FF_; N_src = 2 * FF_; K = D_; kend = D_; g = g_prev; b = b_prev; dst = p.Wb + WE_1 + (size_t)r * 32 * D_; gWo = p.aux + AUX_G1 + r * 32; bWo = p.aux + AUX_B1 + r * 32; }
        else if ((r -= 176) < 128) { const int rg = r >> 2, kq = r & 3; W = p.f1o + (size_t)l * FF_ * D_; N_src = D_; K = FF_; kbeg = 704 * kq; kend = kbeg + 704; src = 32 * rg; dst = p.Wb + WE_2 + (size_t)rg * 32 * FF_; }
        else if ((r -= 128) < 112) { src = proj_src(r, nv); W = p.w_in + (size_t)l * D_ * DIN_; N_src = DIN_; K = D_; kend = D_; g = g0; b = b0; dst = p.Wb + WE_3 + (size_t)r * 32 * D_; gWo = p.aux + AUX_G3 + r * 32; bWo = p.aux + AUX_B3 + r * 32; }
        else if ((r -= 112) < 96) { src = SC_G + 32 * r; W = p.w_in + (size_t)l * D_ * DIN_; N_src = DIN_; K = D_; kend = D_; g = g0; b = b0; dst = p.Wb + WE_4 + (size_t)r * 32 * D_; gWo = p.aux + AUX_G4 + r * 32; bWo = p.aux + AUX_B4 + r * 32; }
        else if ((r -= 96) < 96) { const int br = r >> 5; W = inp[4 + br] + (size_t)l * 512 * D_; N_src = D_; K = 1536; kend = 512; src = 32 * (r & 31); dst = p.Wb + WE_5 + (size_t)(32 * (r & 31)) * 1536 + br * 512; }
        else if ((r -= 96) < 32) { W = p.w_out + (size_t)l * D_ * D_; N_src = D_; K = D_; kend = D_; src = 32 * r; dst = p.Wb + WE_6 + (size_t)r * 32 * D_; }
        else if ((r -= 32) < 176) { const int j = r >> 3, gi = r & 7; src = (gi < 4) ? 128 * j + 32 * gi : FF_ + 128 * j + 32 * (gi - 4);
            W = p.f2i + (size_t)l * D_ * 2 * FF_; N_src = 2 * FF_; K = D_; kend = D_; g = g1; b = b1; dst = p.Wb + WE_7 + (size_t)r * 32 * D_; gWo = p.aux + AUX_G7 + r * 32; bWo = p.aux + AUX_B7 + r * 32; }
        else { r -= 176; const int rg = r >> 2, kq = r & 3; W = p.f2o + (size_t)l * FF_ * D_; N_src = D_; K = FF_; kbeg = 704 * kq; kend = kbeg + 704; src = 32 * rg; dst = p.Wb + WE_8 + (size_t)rg * 32 * FF_; }
        prep_item(W, N_src, K, kbeg, kend, src, nv, g, b, dst, gWo, bWo, scr, lane);
    }
}
__device__ const double ROPE_INV[32] = {1.0, 0.7498942093324559, 0.5623413251903491, 0.4216965034285822, 0.31622776601683794, 0.23713737056616552, 0.1778279410038923, 0.1333521432163324, 0.1, 0.07498942093324558, 0.05623413251903491, 0.042169650342858224, 0.03162277660168379, 0.023713737056616554, 0.01778279410038923, 0.01333521432163324, 0.01, 0.007498942093324558, 0.005623413251903491, 0.004216965034285823, 0.0031622776601683794, 0.0023713737056616554, 0.0017782794100389228, 0.001333521432163324, 0.001, 0.0007498942093324559, 0.0005623413251903491, 0.00042169650342858224, 0.00031622776601683794, 0.00023713737056616554, 0.00017782794100389227, 0.0001333521432163324};
__device__ __forceinline__ double rope_inv(int i) { return ROPE_INV[i]; }
__device__ __forceinline__ void prologue(const Ptrs& p, int gtid, int ngt) {
    for (size_t c = gtid; c < (size_t)T_ * D_ / 8; c += ngt) { const f32x4 a = *(const f32x4*)(p.x + c * 8), b = *(const f32x4*)(p.x + c * 8 + 4);
        *(u32x4*)(p.Yb + blk_off((int)(c >> 7), (int)(c & 127) * 8, D_)) = pack8(a, b); }
    for (size_t c = gtid; c < (size_t)T_ * 8; c += ngt) { f32x4 v = (f32x4){0.f, 0.f, 0.f, 0.f}; if ((c & 7) == 0) v[1] = 1024.0f * (1.0f - LN_EPS_); *(f32x4*)(p.stats + (size_t)T_ * 32 + c * 4) = v; }
    for (size_t c = gtid; c < (size_t)T_ * 32; c += ngt) { const int t = (int)(c >> 5), i = (int)(c & 31); const double ang = (double)p.pos[t] * rope_inv(i);
        const double rev = ang * 0.15915494309189535; const double fr = rev - rint(rev); const float r = (float)(fr * 6.283185307179586);
        p.cosT[c] = __cosf(r); p.sinT[c] = __sinf(r); }
    for (int c = gtid; c < D_; c += ngt) { p.ones[c] = 1.f; p.zeros[c] = 0.f; }
}
__device__ __forceinline__ void combine_a(const Ptrs& p, int gtid, int ngt) {
    for (size_t c = gtid; c < (size_t)T_ * 64; c += ngt) { const size_t t = c >> 6; const int j = (int)(c & 63), h = j >> 3;
        const float L0 = p.LSE[t * 8 + h], L1 = p.LSE[(size_t)T_ * 8 + t * 8 + h], L2 = p.LSE[(size_t)2 * T_ * 8 + t * 8 + h];
        const float mx = fmaxf(L0, fmaxf(L1, L2)); float w0 = fast_exp2(L0 - mx), w1 = fast_exp2(L1 - mx), w2 = fast_exp2(L2 - mx); const float inv = fast_rcp(w0 + w1 + w2); w0 *= inv; w1 *= inv; w2 *= inv;
        bf16_t* o0 = p.OB + t * NO_ + j * 8; const bf16_t* o1 = p.ACX + t * 512 + j * 8; const bf16_t* o2 = p.ACX + (size_t)T_ * 512 + t * 512 + j * 8;
        f32x4 a0, b0, a1, b1, a2, b2; unpack8(*(const u32x4*)o0, a0, b0); unpack8(*(const u32x4*)o1, a1, b1); unpack8(*(const u32x4*)o2, a2, b2);
        *(u32x4*)o0 = pack8(a0 * w0 + a1 * w1 + a2 * w2, b0 * w0 + b1 * w1 + b2 * w2); }
}
__device__ __forceinline__ void final_ln(const Ptrs& p, const float* st, const float* g, const float* b, int gw, int ngw, int lane) {
    for (int row = gw; row < T_; row += ngw) { float mu, rs; row_stats(st, row, lane >> 4, mu, rs);
#pragma unroll
        for (int j = 0; j < 4; ++j) { float* yp = p.Y + (size_t)row * D_ + 256 * j + 4 * lane; const f32x4 v = *(const f32x4*)yp, gg = *(const f32x4*)(g + 256 * j + 4 * lane), bb = *(const f32x4*)(b + 256 * j + 4 * lane);
            *(f32x4*)yp = ((v - mu) * rs) * gg + bb; } }
}


typedef unsigned short bf16;
#define XB_TMO      128
#define XB_XCNT(j)  (256  + 64 * (j))
#define XB_XSUB(j)  (1280 + 64 * (j))
#define XB_XGEN(j)  (2304 + 64 * (j))
#define XB_TOP      3328
#define XB_TOPGEN   3392
#define XCD_BAR_WORDS 3456
#define XB_SPIN_CAP (1u << 18)

__device__ __forceinline__ unsigned xb_ld(unsigned* p)              { return __hip_atomic_load(p, __ATOMIC_RELAXED, __HIP_MEMORY_SCOPE_AGENT); }
__device__ __forceinline__ unsigned xb_add(unsigned* p, unsigned v) { return __hip_atomic_fetch_add(p, v, __ATOMIC_RELAXED, __HIP_MEMORY_SCOPE_AGENT); }
__device__ __forceinline__ unsigned xb_xcc_id() { return (unsigned)__builtin_amdgcn_s_getreg((3 << 11) | 20) & 0xFu; }
#define XB_SPIN(cond, bar) do { unsigned _sp = 0; while (cond) { __builtin_amdgcn_s_sleep(1); \
    if ((++_sp & 255u) == 0u) { if (xb_ld(&(bar)[XB_TMO])) break; if (_sp > XB_SPIN_CAP) { atomicAdd(&(bar)[XB_TMO], 1u); break; } } } } while (0)

struct XcdBarrier {
    unsigned* bar; unsigned x;
    volatile LAS unsigned* st;
};

__device__ __forceinline__ XcdBarrier xcd_barrier_post(unsigned* bar, volatile LAS unsigned* st) {
    XcdBarrier b; b.bar = bar; b.x = xb_xcc_id(); b.st = st;
    if (threadIdx.x == 0) (void)xb_add(&bar[XB_XCNT(b.x)], 1u);
    return b;
}
__device__ __forceinline__ void xcd_barrier_complete(unsigned* bar, unsigned x, unsigned& nloc, unsigned& nx) {
    const unsigned G = gridDim.x * gridDim.y * gridDim.z;
    unsigned sum, cnt, mine, sp = 0u;
    for (;;) {
        sum = 0u; cnt = 0u; mine = 0u;
#pragma unroll
        for (unsigned j = 0; j < 16; ++j) { const unsigned c = xb_ld(&bar[XB_XCNT(j)]); sum += c; cnt += (c > 0u) ? 1u : 0u; mine = (j == x) ? c : mine; }
        if (sum == G) break;
        __builtin_amdgcn_s_sleep(1);
        if ((++sp & 255u) == 0u) { if (xb_ld(&bar[XB_TMO])) break; if (sp > XB_SPIN_CAP) { atomicAdd(&bar[XB_TMO], 1u); break; } }
    }
    nloc = mine > 0u ? mine : 1u; nx = cnt > 0u ? cnt : 1u;
}

__device__ __forceinline__ void xcd_barrier(const XcdBarrier& b) {
    asm volatile("s_waitcnt vmcnt(0)" ::: "memory");
    __syncthreads();
    if (threadIdx.x == 0) {
        unsigned* bar = b.bar;
        __builtin_amdgcn_s_waitcnt(0);
        unsigned nloc = b.st[0], nx = b.st[1];
        if (nloc == 0u) { xcd_barrier_complete(bar, b.x, nloc, nx); b.st[0] = nloc; b.st[1] = nx; }
        const unsigned old = xb_add(&bar[XB_XSUB(b.x)], 1u);
        const unsigned gen = old / nloc;
        if (old + 1u == (gen + 1u) * nloc) {
            __builtin_amdgcn_fence(__ATOMIC_RELEASE, "agent");
            asm volatile("s_waitcnt vmcnt(0)" ::: "memory");
            const unsigned og = xb_add(&bar[XB_TOP], 1u);
            const unsigned tg = og / nx;
            if (og + 1u == (tg + 1u) * nx) xb_add(&bar[XB_TOPGEN], 1u);
            else XB_SPIN(xb_ld(&bar[XB_TOPGEN]) == tg, bar);
            __builtin_amdgcn_fence(__ATOMIC_ACQUIRE, "agent");
            xb_add(&bar[XB_XGEN(b.x)], 1u);
            asm volatile("s_waitcnt vmcnt(0)" ::: "memory");
        } else {
            XB_SPIN(xb_ld(&bar[XB_XGEN(b.x)]) == gen, bar);
            __builtin_amdgcn_fence(__ATOMIC_ACQUIRE, "agent");
            asm volatile("s_waitcnt vmcnt(0)" ::: "memory");
        }
    }
    __syncthreads();
}

constexpr int NWAVES = 8, LDS_BYTES = 131072 + 256, LDS_MISC = 131072;
constexpr size_t WS_CTL = 16 * MiB + 512 * 1024, CTL_BYTES = 16384;
#ifndef DSA_REPS
#define DSA_REPS 1
#endif
#ifndef BAND_REPS
#define BAND_REPS 1
#endif
#ifndef BAND_NQ
#define BAND_NQ 2
#endif
#ifndef G6_REPS
#define G6_REPS 1
#endif
#ifndef ATT_REPS
#define ATT_REPS 1
#endif
#ifndef PREP_REPS
#define PREP_REPS 1
#endif
constexpr int NPHASE = 10 * DEPTH_ + 1;
static_assert(C_LDS_END <= LDS_BYTES && 8 * 8448 <= LDS_BYTES, "LDS map");
struct Args { const float* in[14]; float* out; unsigned char* ws; int lo, hi; };
__global__ void __launch_bounds__(NWAVES * 64, 2) mega(Args a) {
    extern __shared__ __attribute__((aligned(16))) unsigned char lds_raw[];
    LAS unsigned char* lds = (LAS unsigned char*)lds_raw;
    const int wave = __builtin_amdgcn_readfirstlane((int)threadIdx.x >> 6);
#define OTID() ({ int t_ = threadIdx.x; asm volatile("" : "+v"(t_)); t_; })
#define LANE() (OTID() & 63)
#define GTID() (vcu * NWAVES * 64 + OTID())
    const int G = gridDim.x, bx = blockIdx.x, vcu = (G % 8 == 0) ? (bx % 8) * (G / 8) + bx / 8 : bx;
    const int gw = vcu * NWAVES + wave, ngw = G * NWAVES, ngt = G * NWAVES * 64;
    Ptrs p;
    p.x = a.in[0]; p.pos = (const int*)a.in[1]; p.w_in = a.in[2]; p.sink = a.in[3];  p.w_out = a.in[7];
    p.f1i = a.in[8]; p.f1o = a.in[9]; p.f2i = a.in[10]; p.f2o = a.in[11]; p.lng = a.in[12]; p.lnb = a.in[13];
    unsigned char* ws = a.ws;
    p.Y = a.out; p.stats = (float*)(ws + WS_STATS); p.cosT = (float*)(ws + WS_ROPE); p.sinT = p.cosT + (size_t)T_ * 32; p.ones = (float*)(ws + WS_LNV); p.zeros = p.ones + 1024;
    p.aux = (float*)(ws + WS_AUX); p.LSE = (float*)(ws + WS_LSE); p.Yb = (bf16_t*)(ws + WS_YB); p.Wb = (bf16_t*)(ws + WS_W); p.BIG = (bf16_t*)(ws + WS_BIG); p.OB = (bf16_t*)(ws + WS_OBUF); p.ACX = (bf16_t*)(ws + WS_ACX);
#if !MK_MULTI
    cg::grid_group grid = cg::this_grid();
    if (threadIdx.x < 64) ((LAS unsigned*)(lds + LDS_MISC))[threadIdx.x] = 0u;
    __syncthreads();
    XcdBarrier xbar = xcd_barrier_post((unsigned*)(a.ws + WS_CTL), (volatile LAS unsigned*)(lds + LDS_MISC));
#endif
    const int lo = a.lo, hi = a.hi;
#define IN(k) (lo <= (k) && (k) < hi)
#if MK_MULTI
#define SEAM(k) do { } while (0)
#else
#define SEAM(k) do { if (IN(k) && IN((k) + 1)) { if ((k) == 0) grid.sync(); else xcd_barrier(xbar); } } while (0)
#endif
    for (int l = 0; l < DEPTH_; ++l) {
        const int pb = 10 * l;
        const int s0 = 3 * l;
        const float* gp; const float* bp;
        if (IN(pb + 0)) for (int rep_ = 0; rep_ < PREP_REPS; ++rep_) {
#ifndef NO_PREP
 prep_layer(p, a.in, l, lds, gw, ngw, wave, LANE()); if (l == 0) prologue(p, GTID(), ngt);
#endif
 }
        SEAM(pb + 0);
        if (IN(pb + 1)) {
#ifndef NO_G1
 pg8::Gemm g{p.Yb, p.Wb + WE_1, 64, D_, 1}; pg8::StaticOrder S; S.init(T_, 2 * FF_, G, bx);
            EpiSwiglu E{p.BIG, p.stats + (size_t)((s0 + 1) & 1) * T_ * 32, p.aux + AUX_G1, p.aux + AUX_B1};
            pg8::gemm_phase<EpiSwiglu, pg8::StaticOrder, true, true>(lds, g, S, E);
#endif
        }
        SEAM(pb + 1);
        if (IN(pb + 2)) {
#ifndef NO_G2
 pg8::Gemm g{p.BIG, p.Wb + WE_2, 64, FF_, 1}; pg8::StaticOrder S; S.init(T_, D_, G, bx);
            gp = (l == 0) ? p.ones : p.lng + (size_t)((l - 1) * 3 + 2) * D_; bp = (l == 0) ? p.zeros : p.lnb + (size_t)((l - 1) * 3 + 2) * D_;
            EpiResid E{(l == 0) ? p.x : p.Y, p.Y, p.Yb, p.stats + (size_t)((s0 + 1) & 1) * T_ * 32, p.stats + (size_t)(s0 & 1) * T_ * 32, gp, bp, 0.5f};
            pg8::gemm_phase<EpiResid, pg8::StaticOrder, true, true>(lds, g, S, E);
#endif
        }
        SEAM(pb + 2);
        if (IN(pb + 3)) {
#ifndef NO_G3
 pg8::Gemm g{p.Yb, p.Wb + WE_3, 64, D_, 1}; pg8::StaticOrder S; S.init(T_, NP_, G, bx);
            EpiProj E{p.BIG, p.stats + (size_t)(s0 & 1) * T_ * 32, p.aux + AUX_G3, p.aux + AUX_B3, p.cosT, p.sinT};
            pg8::gemm_phase<EpiProj, pg8::StaticOrder, true, true>(lds, g, S, E);
#endif
        }
        SEAM(pb + 3);
        if (IN(pb + 4)) for (int rep_ = 0; rep_ < ATT_REPS; ++rep_) {
#ifndef NO_DSA
            for (int dr_ = 0; dr_ < DSA_REPS; ++dr_) for (int idx = vcu; idx < NB_ * 128; idx += G) { const int k = idx >> 8, v = idx & 255, b = (v >> 5) + 8 * (k & 1), c32 = v & 31, k2 = k >> 1, blk = 32 * k2 + ((k2 & 1) ? 31 - c32 : c32);
                dsa_unit(b, blk, p.BIG, p.OB, lds, wave, OTID()); }
#endif
#ifndef NO_BAND
            LAS unsigned char* vl = lds + C_VST + wave * 4096;
            for (int br_ = 0; br_ < BAND_REPS; ++br_) for (int u = gw; u < 4 * NB_ * 8 * (SEQ_ / (16 * BAND_NQ)); u += ngw) band_unit<BAND_NQ>(u, p.BIG, p.OB, p.ACX, p.LSE, p.sink + l * 8, vl, LANE());
#endif
        }
        SEAM(pb + 4);
        if (IN(pb + 5)) {
#ifndef NO_G5
 combine_a(p, GTID(), ngt);
            pg8::Gemm g{p.Yb, p.Wb + WE_4, 64, D_, 1}; pg8::StaticOrder S; S.init(T_, NG_, G, bx);
            EpiGate E{p.BIG, p.stats + (size_t)(s0 & 1) * T_ * 32, p.aux + AUX_G4, p.aux + AUX_B4};
            pg8::gemm_phase<EpiGate, pg8::StaticOrder, true, true>(lds, g, S, E);
#endif
        }
        SEAM(pb + 5);
        if (IN(pb + 6)) for (int rep_ = 0; rep_ < G6_REPS; ++rep_) {
#ifndef NO_G6
 pg8::Gemm g{p.OB, p.Wb + WE_5, NO_, NO_, 0}; pg8::StaticOrder S; S.init(T_, D_, G, bx);
            EpiBranch E{p.BIG, p.ACX};
            pg8::gemm_phase<EpiBranch, pg8::StaticOrder, true, true>(lds, g, S, E);
#endif
        }
        SEAM(pb + 6);
        if (IN(pb + 7)) {
#ifndef NO_G7
 pg8::Gemm g{p.ACX, p.Wb + WE_6, 64, D_, 1}; pg8::StaticOrder S; S.init(T_, D_, G, bx);
            EpiResid E{p.Y, p.Y, p.Yb, p.stats + (size_t)(s0 & 1) * T_ * 32, p.stats + (size_t)((s0 + 1) & 1) * T_ * 32, p.lng + (size_t)(l * 3 + 0) * D_, p.lnb + (size_t)(l * 3 + 0) * D_, 1.0f};
            pg8::gemm_phase<EpiResid, pg8::StaticOrder, true, true>(lds, g, S, E);
#endif
        }
        SEAM(pb + 7);
        if (IN(pb + 8)) {
#ifndef NO_G8
 pg8::Gemm g{p.Yb, p.Wb + WE_7, 64, D_, 1}; pg8::StaticOrder S; S.init(T_, 2 * FF_, G, bx);
            EpiSwiglu E{p.BIG, p.stats + (size_t)((s0 + 1) & 1) * T_ * 32, p.aux + AUX_G7, p.aux + AUX_B7};
            pg8::gemm_phase<EpiSwiglu, pg8::StaticOrder, true, true>(lds, g, S, E);
#endif
        }
        SEAM(pb + 8);
        if (IN(pb + 9)) {
#ifndef NO_G9
 pg8::Gemm g{p.BIG, p.Wb + WE_8, 64, FF_, 1}; pg8::StaticOrder S; S.init(T_, D_, G, bx);
            EpiResid E{p.Y, p.Y, p.Yb, p.stats + (size_t)((s0 + 1) & 1) * T_ * 32, p.stats + (size_t)(s0 & 1) * T_ * 32, p.lng + (size_t)(l * 3 + 1) * D_, p.lnb + (size_t)(l * 3 + 1) * D_, 0.5f};
            pg8::gemm_phase<EpiResid, pg8::StaticOrder, true, true>(lds, g, S, E);
#endif
        }
        SEAM(pb + 9);
    }
    if (IN(10 * DEPTH_)) final_ln(p, p.stats + (size_t)T_ * 32, p.lng + (size_t)((DEPTH_ - 1) * 3 + 2) * D_, p.lnb + (size_t)((DEPTH_ - 1) * 3 + 2) * D_, gw, ngw, LANE());
#undef IN
#undef SEAM
}

extern "C" void kernel_launch(void* const* d_in, const int* in_sizes, int n_in, void* d_out, int out_size, void* d_ws, size_t ws_size, hipStream_t stream) {
    static int grid = 0;
    if (grid == 0) {
        if (n_in != 14 || in_sizes[0] != T_ * D_ || out_size != T_ * D_ || ws_size < WS_END) { fprintf(stderr, "kernel_launch: unexpected shapes/workspace (n_in %d, ws %zu, need %zu)\n", n_in, ws_size, (size_t)WS_END); grid = -1; return; }
        int dev = 0, cus = 0, per_cu = 0;
        if (hipGetDevice(&dev) != hipSuccess || hipDeviceGetAttribute(&cus, hipDeviceAttributeMultiprocessorCount, dev) != hipSuccess) { grid = -1; return; }
        if (hipFuncSetAttribute((const void*)mega, hipFuncAttributeMaxDynamicSharedMemorySize, LDS_BYTES) != hipSuccess) { fprintf(stderr, "kernel_launch: hipFuncSetAttribute failed\n"); grid = -1; return; }
        if (hipOccupancyMaxActiveBlocksPerMultiprocessor(&per_cu, (const void*)mega, NWAVES * 64, LDS_BYTES) != hipSuccess || per_cu < 1) { fprintf(stderr, "kernel_launch: occupancy query says %d\n", per_cu); per_cu = 1; }
        (void)hipGetLastError();
        grid = cus * 1;
    }
    if (grid < 0) return;
    Args a{};
    for (int i = 0; i < 14; ++i) a.in[i] = (const float*)d_in[i];
    a.out = (float*)d_out; a.ws = (unsigned char*)d_ws;
#if MK_MULTI
    for (int ph = 0; ph < NPHASE; ++ph) { a.lo = ph; a.hi = ph + 1; hipLaunchKernelGGL(mega, dim3(grid), dim3(NWAVES * 64), LDS_BYTES, stream, a); }
#else
    a.lo = 0; a.hi = NPHASE;
    if (hipMemsetAsync((char*)d_ws + WS_CTL, 0, CTL_BYTES, stream) != hipSuccess) { fprintf(stderr, "kernel_launch: memset failed\n"); return; }
    void* args[] = {&a};
    hipError_t e = hipLaunchCooperativeKernel((const void*)mega, dim3(grid), dim3(NWAVES * 64), args, LDS_BYTES, stream);
    if (e != hipSuccess) fprintf(stderr, "kernel_launch: cooperative launch failed: %s (grid %d)\n", hipGetErrorString(e), grid);
#endif
}
```
